# Optimizing an MI355X kernel written in HIP

```python
import jax, jax.numpy as jnp
from jax import lax
import numpy as np

D_MODEL = 2048
BATCH = 4
SEQ = 2048
DEPTH = 2
DEC_BATCH = 128
DEC_SEQ = 8
PAST_LEN = 16384
PAGE_SIZE = 128

N_HEADS = 4
D_QK = D_MODEL // 2
D_V = D_MODEL
DK_HEAD = D_QK // N_HEADS
DV_HEAD = D_V // N_HEADS
GATE_RANK = 16
GATE_NORMALIZER = 16
CHUNK = 16
D_POOL = D_MODEL // 2
POOL_GROUPS = 4
POOL_WINDOWS = (2, 4, 8, 16)
POOL_BUF = 15
POOL_IN_G = D_POOL // POOL_GROUPS
POOL_OUT_G = D_MODEL // POOL_GROUPS
N_IN = 2 * D_QK + 2 * D_V + D_POOL + 2 * D_MODEL + GATE_RANK
D_FF = ((8 * D_MODEL + 3 * 256 - 1) // (3 * 256)) * 256
EPS = 1e-6

kernel_name = "gla_pool_hybrid_adaln_decode_step"


def _rmsnorm(x, g):
    xf = x.astype(jnp.float32)
    y = xf * lax.rsqrt(jnp.mean(xf * xf, axis=-1, keepdims=True) + EPS)
    return (y * g.astype(jnp.float32)).astype(x.dtype)


def _gla(q, k, v, loga, s0):
    B, L, H, _ = q.shape
    n = -(-L // CHUNK)
    pad = n * CHUNK - L

    def prep(a):
        a = jnp.pad(a.astype(jnp.float32), ((0, 0), (0, pad), (0, 0), (0, 0)))
        return a.reshape(B, n, CHUNK, H, a.shape[-1]).transpose(1, 0, 3, 2, 4)

    q, k, v, loga = prep(q), prep(k), prep(v), prep(loga)
    b = jnp.cumsum(loga, axis=3)
    b_last = b[:, :, :, -1:, :]
    qe = q * jnp.exp(b)
    ke = k * jnp.exp(-b)
    kd = k * jnp.exp(b_last - b)
    decay = jnp.exp(b_last[:, :, :, 0, :])
    mask = jnp.tril(jnp.ones((CHUNK, CHUNK), dtype=bool))
    att = jnp.where(mask, jnp.einsum('nbhcd,nbhsd->nbhcs', qe, ke), 0.0)
    o_intra = jnp.einsum('nbhcs,nbhse->nbhce', att, v)

    def step(s, inp):
        qe_n, kd_n, v_n, dec_n = inp
        o = jnp.einsum('bhcd,bhde->bhce', qe_n, s)
        s = dec_n[..., None] * s + jnp.einsum('bhcd,bhce->bhde', kd_n, v_n)
        return s, o

    s_fin, o_inter = lax.scan(step, s0.astype(jnp.float32), (qe, kd, v, decay))
    o = (o_intra + o_inter).transpose(1, 0, 3, 2, 4).reshape(B, n * CHUNK, H, DV_HEAD)[:, :L]
    return o, s_fin


def _pool(u_ext, pos0, w_pool, pool_scale):
    B, T, _ = u_ext.shape
    L = T - POOL_BUF
    uf = u_ext.astype(jnp.float32).reshape(B, T, POOL_GROUPS, POOL_IN_G)
    cs = jnp.concatenate([jnp.zeros((B, 1, POOL_GROUPS, POOL_IN_G), jnp.float32),
                          jnp.cumsum(uf, axis=1)], axis=1)
    end = cs[:, POOL_BUF + 1:]
    u_new = uf[:, POOL_BUF:]
    pos = pos0 + jnp.arange(L)
    outs = []
    for g, w in enumerate(POOL_WINDOWS):
        start = cs[:, POOL_BUF + 1 - w: POOL_BUF + 1 - w + L, g]
        cnt = jnp.minimum(pos + 1, w).astype(jnp.float32)[None, :, None]
        outs.append((end[:, :, g] - start) / cnt - u_new[:, :, g])
    d = jnp.stack(outs, axis=2).astype(u_ext.dtype)
    y = jnp.einsum('blgi,gio->blgo', d, w_pool).reshape(B, L, D_MODEL)
    return y * pool_scale


def _layer(x, c, s0, buf0, pos0, w_ada, b_ada, norm1_g, w_in, w_a2, b_a, gla_norm_g,
           w_pool, pool_scale, w_o, norm2_g, w_gu, w_down):
    B, L, _ = x.shape
    mod = jax.nn.silu(c) @ w_ada + b_ada
    sh1, sc1, g1, sh2, sc2, g2 = [m[:, None, :] for m in jnp.split(mod, 6, axis=-1)]

    h = _rmsnorm(x, norm1_g) * (1 + sc1) + sh1
    p = h @ w_in
    sizes = [D_QK, D_QK, D_V, D_V, D_POOL, D_MODEL, D_MODEL]
    idx = [int(i) for i in np.cumsum(sizes)]
    q, k, v, og, u, ga, gb, alr = jnp.split(p, idx, axis=-1)
    gk = alr @ w_a2 + b_a
    loga = jax.nn.log_sigmoid(gk.astype(jnp.float32)) / GATE_NORMALIZER
    q = q.reshape(B, L, N_HEADS, DK_HEAD) * (DK_HEAD ** -0.5)
    k = k.reshape(B, L, N_HEADS, DK_HEAD)
    v = v.reshape(B, L, N_HEADS, DV_HEAD)
    o, s_new = _gla(q, k, v, loga.reshape(B, L, N_HEADS, DK_HEAD), s0)
    o = _rmsnorm(o, gla_norm_g).reshape(B, L, D_V).astype(x.dtype)
    y_a = o * jax.nn.silu(og)

    u_ext = jnp.concatenate([buf0.astype(u.dtype), u], axis=1)
    y_b = _pool(u_ext, pos0, w_pool, pool_scale)
    buf_new = u_ext[:, -POOL_BUF:]

    merged = jax.nn.sigmoid(ga) * y_a + jax.nn.sigmoid(gb) * y_b
    x = x + g1 * (merged @ w_o)

    h2 = _rmsnorm(x, norm2_g) * (1 + sc2) + sh2
    gate, up = jnp.split(h2 @ w_gu, 2, axis=-1)
    x = x + g2 * ((jax.nn.silu(gate) * up) @ w_down)
    return x, s_new, buf_new


def setup_inputs(seed: int = 0) -> dict:
    key = jax.random.key(seed)
    ks = jax.random.split(key, 24)
    f32 = jnp.float32
    nrm = lambda k, s, sc: jax.random.normal(k, s, f32) * sc
    return {
        "x_prompt": nrm(ks[0], (BATCH, SEQ, D_MODEL), 1.0),
        "x_sample": nrm(ks[1], (DEC_BATCH, DEC_SEQ, D_MODEL), 1.0),
        "state_gla": nrm(ks[2], (DEPTH, DEC_BATCH, N_HEADS, DK_HEAD, DV_HEAD), 1.0),
        "state_pool": nrm(ks[3], (DEPTH, DEC_BATCH, POOL_BUF, D_POOL), 1.0),
        "c_prompt": nrm(ks[4], (BATCH, D_MODEL), 1.0),
        "c_sample": nrm(ks[5], (DEC_BATCH, D_MODEL), 1.0),
        "w_ada": nrm(ks[6], (DEPTH, D_MODEL, 6 * D_MODEL), 0.5 * D_MODEL ** -0.5),
        "b_ada": nrm(ks[7], (DEPTH, 6 * D_MODEL), 0.02),
        "norm1_g": 1.0 + nrm(ks[8], (DEPTH, D_MODEL), 0.1),
        "w_in": nrm(ks[9], (DEPTH, D_MODEL, N_IN), D_MODEL ** -0.5),
        "w_a2": nrm(ks[10], (DEPTH, GATE_RANK, D_QK), GATE_RANK ** -0.5),
        "b_a": nrm(ks[11], (DEPTH, D_QK), 0.1),
        "gla_norm_g": 1.0 + nrm(ks[12], (DEPTH, DV_HEAD), 0.1),
        "w_pool": nrm(ks[13], (DEPTH, POOL_GROUPS, POOL_IN_G, POOL_OUT_G), POOL_IN_G ** -0.5),
        "pool_scale": 1.0 + nrm(ks[14], (DEPTH, D_MODEL), 0.1),
        "w_o": nrm(ks[15], (DEPTH, D_MODEL, D_MODEL), D_MODEL ** -0.5),
        "norm2_g": 1.0 + nrm(ks[16], (DEPTH, D_MODEL), 0.1),
        "w_gu": nrm(ks[17], (DEPTH, D_MODEL, 2 * D_FF), D_MODEL ** -0.5),
        "w_down": nrm(ks[18], (DEPTH, D_FF, D_MODEL), D_FF ** -0.5),
        "final_norm_g": 1.0 + nrm(ks[19], (D_MODEL,), 0.1),
    }


def reference(x_prompt, x_sample, state_gla, state_pool, c_prompt, c_sample,
              w_ada, b_ada, norm1_g, w_in, w_a2, b_a, gla_norm_g, w_pool, pool_scale,
              w_o, norm2_g, w_gu, w_down, final_norm_g):
    xp, xs = x_prompt, x_sample
    gla_p, pool_p, gla_s, pool_s = [], [], [], []
    for l in range(DEPTH):
        lw = (w_ada[l], b_ada[l], norm1_g[l], w_in[l], w_a2[l], b_a[l], gla_norm_g[l],
              w_pool[l], pool_scale[l], w_o[l], norm2_g[l], w_gu[l], w_down[l])
        s0_p = jnp.zeros((BATCH, N_HEADS, DK_HEAD, DV_HEAD), jnp.float32)
        buf0_p = jnp.zeros((BATCH, POOL_BUF, D_POOL), xp.dtype)
        xp, s_p, b_p = _layer(xp, c_prompt, s0_p, buf0_p, 0, *lw)
        xs, s_s, b_s = _layer(xs, c_sample, state_gla[l], state_pool[l], PAST_LEN, *lw)
        gla_p.append(s_p)
        pool_p.append(b_p)
        gla_s.append(s_s)
        pool_s.append(b_s)
    y_prompt = _rmsnorm(xp, final_norm_g)
    y_sample = _rmsnorm(xs, final_norm_g)
    return (y_prompt, y_sample, jnp.stack(gla_p), jnp.stack(pool_p), jnp.stack(gla_s), jnp.stack(pool_s))
```

```cpp
#include <hip/hip_runtime.h>
#include <cstdio>
#include <cstdint>
#ifndef MK_N_LAUNCHES
#define MK_N_LAUNCHES 1
#endif
#ifndef PROBE_DUP
#define PROBE_DUP 0
#endif
namespace pg8 {
#define PG8_LAS __attribute__((address_space(3)))
typedef unsigned short bf16_t;
typedef short bf16x8 __attribute__((ext_vector_type(8)));
typedef float f32x4 __attribute__((ext_vector_type(4)));
typedef unsigned u32x4 __attribute__((ext_vector_type(4)));
constexpr int BM = 256, BK = 64, HALF = 128, HTB = HALF * BK * 2  , STAGE_BYTES = 8 * HTB, NXCD = 8, WGM = 8;

__host__ __device__ __forceinline__ int lds_byte(int r, int c) { const int st = (r >> 4) * 2 + (c >> 5), rr = r & 15, cc = c & 31, ob = rr * 64 + cc * 2; return st * 1024 + (ob ^ (((ob >> 9) & 1) << 5)); }
__host__ __device__ __forceinline__ void stage_rc(int b, int& R, int& C) { const int st = b / 1024, sb = b % 1024, swz = sb ^ (((sb >> 9) & 1) << 5); R = (st >> 1) * 16 + swz / 64; C = (st & 1) * 32 + (swz % 64) / 2; }
__host__ __device__ __forceinline__ int perm32(int rho) { const int n = rho >> 4, i = rho & 15; return 8 * (i >> 2) + 4 * n + (i & 3); }

struct Unit { int pm, pn, kofs, nt, slice; };
struct Gemm { const bf16_t* A; const bf16_t* Bt; int M, N, K, lda, ldb, grp_div, grp_a_off; };

struct StaticOrder {
    int nM, nN, nwg, G, c, ntk;
    __host__ __device__ void init(int M, int N, int G_, int c_, int K) { nM = M / BM; nN = N / BM; nwg = nM * nN; G = G_; c = c_; ntk = K / BK; }
    __host__ __device__ void tile(int L, Unit& u) const {
        int wgid = L; { const int q = nwg / NXCD, r = nwg % NXCD, xcd = wgid % NXCD, off = wgid / NXCD; wgid = (xcd < r ? xcd * (q + 1) : r * (q + 1) + (xcd - r) * q) + off; }
        const int nig = WGM * nN, gid = wgid / nig, fm = gid * WGM, gsz = (nM - fm) < WGM ? (nM - fm) : WGM;
        u.pm = fm + ((wgid % nig) % gsz); u.pn = (wgid % nig) / gsz; u.kofs = 0; u.nt = ntk; u.slice = -1;
    }
    __host__ __device__ bool next(int i, Unit& u) const { const long L = (long)i * G + c; if (L >= nwg) return false; tile((int)L, u); return true; }
    __device__ __forceinline__ void a_ready(const Unit&) const {}
    __device__ __forceinline__ void done(const Unit&) const {}
};
struct SplitOrder {
    StaticOrder P; int G, c, ntk;
    __host__ __device__ void init(int G_, int c_, int K) { P.init(8192, 2048, G_, c_, K); G = G_; c = c_; ntk = K / BK; }
    __host__ __device__ bool next(int i, Unit& u) const {
        const long L = (long)i * G + c;
        if (L < 256) { P.tile((int)L, u); return true; }
        const int q = (int)L - 256; if (q >= 256) return false;
        const int t = q >> 3, s = q & 7, h = ntk >> 1, p0 = (s * h) >> 3, p1 = ((s + 1) * h) >> 3;
        u.pm = 32 + (t >> 3); u.pn = t & 7; u.kofs = 2 * p0 * BK; u.nt = 2 * (p1 - p0); u.slice = s; return true;
    }
    __device__ __forceinline__ void a_ready(const Unit&) const {}
    __device__ __forceinline__ void done(const Unit&) const {}
};

typedef __bf16 bf16x2_t __attribute__((ext_vector_type(2)));
typedef float f32x2_t __attribute__((ext_vector_type(2)));
__device__ __forceinline__ unsigned cvt_pk_bf16(float lo, float hi) { const f32x2_t v = {lo, hi}; const bf16x2_t r = __builtin_convertvector(v, bf16x2_t); return __builtin_bit_cast(unsigned, r); }
__device__ __forceinline__ int seq_of_row(int r) { return r < 8192 ? (r >> 11) : 4 + ((r - 8192) >> 3); }

struct EpiF32Bias {
    static constexpr bool PERM = false, AFTER_DRAIN = false;
    float* C; int ldc; const float* bias;
    __device__ __forceinline__ void operator()(const f32x4 (&acc)[2][2][4][2], const Unit& u, int wr, int wc, int fr, int fq) const {
        const int row0 = u.pm * BM + wr * 64 + fr, col0 = u.pn * BM + wc * 32 + 4 * fq;
        f32x4 bv[2][2];
#pragma unroll
        for (int bj = 0; bj < 2; ++bj)
#pragma unroll
            for (int n = 0; n < 2; ++n) bv[bj][n] = *(const f32x4*)(bias + col0 + bj * HALF + n * 16);
#pragma unroll
        for (int ai = 0; ai < 2; ++ai)
#pragma unroll
            for (int m = 0; m < 4; ++m) { float* rowp = C + (size_t)(row0 + ai * HALF + m * 16) * ldc + col0;
#pragma unroll
                for (int bj = 0; bj < 2; ++bj)
#pragma unroll
                    for (int n = 0; n < 2; ++n) *(f32x4*)(rowp + bj * HALF + n * 16) = acc[ai][bj][m][n] + bv[bj][n]; }
    }
};
struct EpiBf16Plain {
    static constexpr bool PERM = true, AFTER_DRAIN = false;
    bf16_t* O; int ldc;
    __device__ __forceinline__ void operator()(const f32x4 (&acc)[2][2][4][2], const Unit& u, int wr, int wc, int fr, int fq) const {
        const int row0 = u.pm * BM + wr * 64 + fr, col0 = u.pn * BM + wc * 32 + 8 * fq;
#pragma unroll
        for (int ai = 0; ai < 2; ++ai)
#pragma unroll
            for (int m = 0; m < 4; ++m) { bf16_t* rowp = O + (size_t)(row0 + ai * HALF + m * 16) * ldc + col0;
#pragma unroll
                for (int bj = 0; bj < 2; ++bj) { const f32x4 v0 = acc[ai][bj][m][0], v1 = acc[ai][bj][m][1];
                    u32x4 w; w.x = cvt_pk_bf16(v0[0], v0[1]); w.y = cvt_pk_bf16(v0[2], v0[3]); w.z = cvt_pk_bf16(v1[0], v1[1]); w.w = cvt_pk_bf16(v1[2], v1[3]);
                    *(u32x4*)(rowp + bj * HALF) = w; } }
    }
};
struct EpiWin {
    static constexpr bool PERM = true, AFTER_DRAIN = false;
    bf16_t* O; int Mrows;
    __device__ __forceinline__ void operator()(const f32x4 (&acc)[2][2][4][2], const Unit& u, int wr, int wc, int fr, int fq) const {
        const int row0 = u.pm * BM + wr * 64 + fr, pn = u.pn; const bool wide = (pn >= 8 && pn < 24) || (pn >= 28 && pn < 44);
        const int ldc = wide ? 512 : 256; bf16_t* base = O + (size_t)(wide ? (pn & ~1) : pn) * Mrows * 256 + (wide ? (pn & 1) * 256 : 0) + wc * 32 + 8 * fq;
#pragma unroll
        for (int ai = 0; ai < 2; ++ai)
#pragma unroll
            for (int m = 0; m < 4; ++m) { bf16_t* rowp = base + (size_t)(row0 + ai * HALF + m * 16) * ldc;
#pragma unroll
                for (int bj = 0; bj < 2; ++bj) { const f32x4 v0 = acc[ai][bj][m][0], v1 = acc[ai][bj][m][1];
                    u32x4 w; w.x = cvt_pk_bf16(v0[0], v0[1]); w.y = cvt_pk_bf16(v0[2], v0[3]); w.z = cvt_pk_bf16(v1[0], v1[1]); w.w = cvt_pk_bf16(v1[2], v1[3]);
                    *(u32x4*)(rowp + bj * HALF) = w; } }
    }
};
struct EpiMerge {
    static constexpr bool PERM = true, AFTER_DRAIN = false;
    bf16_t* MG; const bf16_t* O; const bf16_t* Pb; const float* ssq; const float* gng; const float* psc; int Mrows;
    __device__ __forceinline__ static float sg(float x) { return __builtin_amdgcn_rcpf(1.0f + __builtin_amdgcn_exp2f(-1.44269504089f * x)); }
    __device__ __forceinline__ static float lo(unsigned w) { return __builtin_bit_cast(float, w << 16); }
    __device__ __forceinline__ static float hi(unsigned w) { return __builtin_bit_cast(float, w & 0xffff0000u); }
    __device__ __forceinline__ void operator()(const f32x4 (&acc)[2][2][4][2], const Unit& u, int wr, int wc, int fr, int fq) const {
        const int row0 = u.pm * BM + wr * 64 + fr, h = u.pn >> 1, e0 = (u.pn & 1) * 256 + wc * 32 + 8 * fq;
        const size_t PLs = (size_t)Mrows * 256;
        const bf16_t* pog = Pb + (size_t)(16 + 2 * h) * PLs + e0; const bf16_t* pga = Pb + (size_t)(28 + 2 * h) * PLs + e0; const bf16_t* pgb = Pb + (size_t)(36 + 2 * h) * PLs + e0;
        f32x4 gn[2][2], ps[2][2];
#pragma unroll
        for (int bj = 0; bj < 2; ++bj)
#pragma unroll
            for (int n = 0; n < 2; ++n) { gn[bj][n] = *(const f32x4*)(gng + e0 + 128 * bj + 4 * n); ps[bj][n] = *(const f32x4*)(psc + 512 * h + e0 + 128 * bj + 4 * n); }
#pragma unroll
        for (int ai = 0; ai < 2; ++ai)
#pragma unroll
            for (int m = 0; m < 4; ++m) { const int row = row0 + ai * HALF + m * 16;
                const f32x4* sp = (const f32x4*)(ssq + ((size_t)row * 4 + h) * 16); const f32x4 s0 = sp[0], s1 = sp[1], s2 = sp[2], s3 = sp[3];
                const float ss = ((s0[0] + s0[1]) + (s0[2] + s0[3])) + ((s1[0] + s1[1]) + (s1[2] + s1[3])) + ((s2[0] + s2[1]) + (s2[2] + s2[3])) + ((s3[0] + s3[1]) + (s3[2] + s3[3]));
                const float rstd = __builtin_amdgcn_rsqf(ss * (1.0f / 512.0f) + 1e-6f);
#pragma unroll
                for (int bj = 0; bj < 2; ++bj) { const size_t ro = (size_t)row * 512 + 128 * bj;
                    const u32x4 ov = *(const u32x4*)(O + (size_t)row * 2048 + 512 * h + e0 + 128 * bj), ogv = *(const u32x4*)(pog + ro), gav = *(const u32x4*)(pga + ro), gbv = *(const u32x4*)(pgb + ro);
                    float res[8];
#pragma unroll
                    for (int q = 0; q < 8; ++q) { const unsigned ow = ov[q >> 1], gw_ = ogv[q >> 1], aw = gav[q >> 1], bw = gbv[q >> 1];
                        const float o = (q & 1) ? hi(ow) : lo(ow), og = (q & 1) ? hi(gw_) : lo(gw_), ga = (q & 1) ? hi(aw) : lo(aw), gb = (q & 1) ? hi(bw) : lo(bw);
                        const float ya = o * rstd * gn[bj][q >> 2][q & 3] * (og * sg(og)), yb = acc[ai][bj][m][q >> 2][q & 3] * ps[bj][q >> 2][q & 3];
                        res[q] = sg(ga) * ya + sg(gb) * yb; }
                    u32x4 w; w.x = cvt_pk_bf16(res[0], res[1]); w.y = cvt_pk_bf16(res[2], res[3]); w.z = cvt_pk_bf16(res[4], res[5]); w.w = cvt_pk_bf16(res[6], res[7]);
                    *(u32x4*)(MG + (size_t)row * 2048 + 512 * h + e0 + 128 * bj) = w; }
                if (m & 1) asm volatile("" ::: "memory"); }
    }
};
struct EpiResGate {
    static constexpr bool PERM = false, AFTER_DRAIN = false;
    const float* baseP; const float* baseS; float* out; int ldc; const float* gate; int gate_ld; bf16_t* slab;
    __device__ __forceinline__ void operator()(const f32x4 (&acc)[2][2][4][2], const Unit& u, int wr, int wc, int fr, int fq) const {
        const int row0 = u.pm * BM + wr * 64 + fr, col0 = u.pn * BM + wc * 32 + 4 * fq;
        if (u.slice >= 0) {
#pragma unroll
            for (int ai = 0; ai < 2; ++ai)
#pragma unroll
                for (int m = 0; m < 4; ++m) { bf16_t* op = slab + ((size_t)u.slice * 1024 + (row0 + ai * HALF + m * 16 - 8192)) * ldc + col0;
#pragma unroll
                    for (int bj = 0; bj < 2; ++bj)
#pragma unroll
                        for (int n = 0; n < 2; ++n) { const f32x4 v = acc[ai][bj][m][n]; typedef unsigned u32x2 __attribute__((ext_vector_type(2)));
                            *(u32x2*)(op + bj * HALF + n * 16) = (u32x2){cvt_pk_bf16(v[0], v[1]), cvt_pk_bf16(v[2], v[3])}; } }
            return;
        }
#pragma unroll
        for (int ai = 0; ai < 2; ++ai)
#pragma unroll
            for (int m = 0; m < 4; ++m) { const int row = row0 + ai * HALF + m * 16;
                const float* bp = (row < 8192 ? baseP + (size_t)row * ldc : baseS + (size_t)(row - 8192) * ldc) + col0;
                const float* gp = gate + (size_t)seq_of_row(row) * gate_ld + col0; float* op = out + (size_t)row * ldc + col0;
#pragma unroll
                for (int bj = 0; bj < 2; ++bj)
#pragma unroll
                    for (int n = 0; n < 2; ++n) { const f32x4 b = *(const f32x4*)(bp + bj * HALF + n * 16), gt = *(const f32x4*)(gp + bj * HALF + n * 16);
                        *(f32x4*)(op + bj * HALF + n * 16) = b + gt * acc[ai][bj][m][n]; }
                if (m & 1) asm volatile("" ::: "memory"); }
    }
};
struct EpiSwiGLU {
    static constexpr bool PERM = true, AFTER_DRAIN = false;
    bf16_t* O; int ldc;
    __device__ __forceinline__ static float act(float g, float up) { return g * __builtin_amdgcn_rcpf(1.0f + __builtin_amdgcn_exp2f(-1.44269504089f * g)) * up; }
    __device__ __forceinline__ void operator()(const f32x4 (&acc)[2][2][4][2], const Unit& u, int wr, int wc, int fr, int fq) const {
        const int row0 = u.pm * BM + wr * 64 + fr, col0 = u.pn * HALF + wc * 32 + 8 * fq;
#pragma unroll
        for (int ai = 0; ai < 2; ++ai)
#pragma unroll
            for (int m = 0; m < 4; ++m) { bf16_t* rowp = O + (size_t)(row0 + ai * HALF + m * 16) * ldc + col0;
                const f32x4 g0 = acc[ai][0][m][0], g1 = acc[ai][0][m][1], u0 = acc[ai][1][m][0], u1 = acc[ai][1][m][1];
                u32x4 w; w.x = cvt_pk_bf16(act(g0[0], u0[0]), act(g0[1], u0[1])); w.y = cvt_pk_bf16(act(g0[2], u0[2]), act(g0[3], u0[3]));
                w.z = cvt_pk_bf16(act(g1[0], u1[0]), act(g1[1], u1[1])); w.w = cvt_pk_bf16(act(g1[2], u1[2]), act(g1[3], u1[3]));
                *(u32x4*)rowp = w; }
    }
};

template <class Epi, class Sched, bool ALIGN_EPI = false, bool SP2 = false>
__device__ __forceinline__ void gemm_phase(PG8_LAS unsigned char* lds, const Gemm g, const Sched& S, const Epi& E) {
    const int tid = threadIdx.x, wid = __builtin_amdgcn_readfirstlane(tid >> 6), lane = tid & 63, wr = wid >> 2, wc = wid & 3, fr = lane & 15, fq = lane >> 4;
    unsigned voffA[2], voffB[2];
#pragma unroll
    for (int i = 0; i < 2; ++i) { int R, C; stage_rc(tid * 16 + i * 8192, R, C); const int Rb = Epi::PERM ? ((R & ~31) + perm32(R & 31)) : R;
        voffA[i] = (unsigned)(R * g.lda + C) * 2u; voffB[i] = (unsigned)(Rb * g.ldb + C) * 2u; }
    const size_t kstep = (size_t)(BK * 2);
    const size_t hstepA = (size_t)HALF * g.lda * 2, hstepB = (size_t)HALF * g.ldb * 2;
    const size_t tstepA = 2 * hstepA, tstepB = 2 * hstepB;
    const unsigned ldsw = (unsigned)wid * 1024u;
    const int aoff = lds_byte(wr * 64 + fr, fq * 8), boff = lds_byte(wc * 32 + fr, fq * 8);
#define PG8_SA(b, h) (((b) * 2 + (h)) * HTB)
#define PG8_SB(b, h) ((4 + (b) * 2 + (h)) * HTB)
#define PG8_STAGE(bufoff, gbase, voff) do { _Pragma("unroll") for (int _i = 0; _i < 2; ++_i) \
        __builtin_amdgcn_global_load_lds((const unsigned*)((const char*)(gbase) + (voff)[_i]), (PG8_LAS unsigned*)(lds + (bufoff) + ldsw + _i * 8192), 16, 0, 0); } while (0)
#define PG8_LDA(dst, b, h) do { _Pragma("unroll") for (int m = 0; m < 4; ++m) _Pragma("unroll") for (int k = 0; k < 2; ++k) dst[m][k] = *(const PG8_LAS bf16x8*)(lds + PG8_SA(b, h) + aoff + m * 2048 + k * 1024); } while (0)
#define PG8_LDB(dst, b, h) do { _Pragma("unroll") for (int n = 0; n < 2; ++n) _Pragma("unroll") for (int k = 0; k < 2; ++k) dst[n][k] = *(const PG8_LAS bf16x8*)(lds + PG8_SB(b, h) + boff + n * 2048 + k * 1024); } while (0)
#define PG8_MMA(ai, bj, At, Bt) do { __builtin_amdgcn_s_setprio(1); _Pragma("unroll") for (int m = 0; m < 4; ++m) _Pragma("unroll") for (int n = 0; n < 2; ++n) _Pragma("unroll") for (int k = 0; k < 2; ++k) \
        acc[ai][bj][m][n] = __builtin_amdgcn_mfma_f32_16x16x32_bf16(Bt[n][k], At[m][k], acc[ai][bj][m][n], 0, 0, 0); __builtin_amdgcn_s_setprio(0); } while (0)
#define PG8_WAIT_V(n) asm volatile("s_waitcnt vmcnt(" #n ")" ::: "memory")
#define PG8_WAIT_L(n) asm volatile("s_waitcnt lgkmcnt(" #n ")" ::: "memory")
#define PG8_BAR __builtin_amdgcn_s_barrier()
#define PG8_SCHED __builtin_amdgcn_sched_barrier(0)
    Unit cur, nxt; int ui = 0;
    if (!S.next(0, cur)) return;
    f32x4 acc[2][2][4][2];
#pragma unroll
    for (int a = 0; a < 2; ++a)
#pragma unroll
        for (int b = 0; b < 2; ++b)
#pragma unroll
            for (int m = 0; m < 4; ++m)
#pragma unroll
                for (int n = 0; n < 2; ++n) acc[a][b][m][n] = (f32x4){0.f, 0.f, 0.f, 0.f};
    bf16x8 At[4][2], B0[2][2], B1[2][2];
    const char* cA = (const char*)g.A + (size_t)cur.pm * tstepA + (size_t)(cur.pn / g.grp_div) * g.grp_a_off + (size_t)cur.kofs * 2; const char* cB = (const char*)g.Bt + (size_t)cur.pn * tstepB + (size_t)cur.kofs * 2;
    S.a_ready(cur);
    if constexpr (SP2) {
        PG8_STAGE(PG8_SB(0, 0), cB, voffB); PG8_STAGE(PG8_SB(0, 1), cB + hstepB, voffB); PG8_STAGE(PG8_SA(0, 0), cA, voffA); PG8_STAGE(PG8_SA(0, 1), cA + hstepA, voffA);
        if (wr == 1) PG8_BAR;
        PG8_WAIT_V(2); PG8_BAR;
        PG8_STAGE(PG8_SB(1, 0), cB + kstep, voffB); PG8_STAGE(PG8_SA(1, 0), cA + kstep, voffA); PG8_STAGE(PG8_SB(1, 1), cB + hstepB + kstep, voffB);
        PG8_WAIT_V(6); PG8_BAR;
    } else {
        PG8_STAGE(PG8_SB(0, 0), cB, voffB); PG8_STAGE(PG8_SA(0, 0), cA, voffA); PG8_STAGE(PG8_SB(0, 1), cB + hstepB, voffB); PG8_STAGE(PG8_SA(0, 1), cA + hstepA, voffA);
        if (wr == 1) PG8_BAR;
        PG8_WAIT_V(4); PG8_BAR;
        PG8_STAGE(PG8_SB(1, 0), cB + kstep, voffB); PG8_STAGE(PG8_SA(1, 0), cA + kstep, voffA); PG8_STAGE(PG8_SB(1, 1), cB + hstepB + kstep, voffB);
        PG8_WAIT_V(6); PG8_BAR;
    }
    for (;;) {
        const bool has_next = S.next(ui + 1, nxt);
        const char* nA = has_next ? (const char*)g.A + (size_t)nxt.pm * tstepA + (size_t)(nxt.pn / g.grp_div) * g.grp_a_off + (size_t)nxt.kofs * 2 : cA; const char* nB = has_next ? (const char*)g.Bt + (size_t)nxt.pn * tstepB + (size_t)nxt.kofs * 2 : cB;
        const int nt = cur.nt;
        for (int t = 0; t < nt; t += 2) {
            const bool last = (t == nt - 2);
            const char* a1 = cA + (size_t)(t + 1) * kstep;
            const char* a2 = last ? nA : cA + (size_t)(t + 2) * kstep; const char* b2 = last ? nB : cB + (size_t)(t + 2) * kstep;
            const char* a3 = a2 + kstep; const char* b3 = b2 + kstep;
            if (last && has_next) S.a_ready(nxt);
            if constexpr (SP2) {
            PG8_LDB(B0, 0, 0); PG8_LDB(B1, 0, 1); PG8_SCHED; PG8_LDA(At, 0, 0); PG8_STAGE(PG8_SA(1, 1), a1 + hstepA, voffA);
            PG8_WAIT_V(8); PG8_WAIT_L(0); PG8_BAR; PG8_MMA(0, 0, At, B0); PG8_MMA(0, 1, At, B1); PG8_BAR; PG8_SCHED;
            PG8_LDA(At, 0, 1); PG8_STAGE(PG8_SB(0, 0), b2, voffB); PG8_STAGE(PG8_SB(0, 1), b2 + hstepB, voffB); PG8_STAGE(PG8_SA(0, 0), a2, voffA);
            PG8_WAIT_V(8); PG8_WAIT_L(0); PG8_BAR; PG8_MMA(1, 0, At, B0); PG8_MMA(1, 1, At, B1); PG8_BAR; PG8_SCHED;
            PG8_LDB(B0, 1, 0); PG8_LDB(B1, 1, 1); PG8_SCHED; PG8_LDA(At, 1, 0); PG8_STAGE(PG8_SA(0, 1), a2 + hstepA, voffA);
            PG8_WAIT_V(8); PG8_WAIT_L(0); PG8_BAR; PG8_MMA(0, 0, At, B0); PG8_MMA(0, 1, At, B1); PG8_BAR; PG8_SCHED;
            PG8_LDA(At, 1, 1); PG8_STAGE(PG8_SB(1, 0), b3, voffB); PG8_STAGE(PG8_SB(1, 1), b3 + hstepB, voffB); PG8_STAGE(PG8_SA(1, 0), a3, voffA);
            PG8_WAIT_V(8); PG8_WAIT_L(0); PG8_BAR; PG8_MMA(1, 0, At, B0); PG8_MMA(1, 1, At, B1); PG8_BAR; PG8_SCHED;
            } else {
            PG8_LDB(B0, 0, 0); PG8_SCHED; PG8_LDA(At, 0, 0); PG8_STAGE(PG8_SA(1, 1), a1 + hstepA, voffA);
            PG8_WAIT_L(8); PG8_BAR; PG8_WAIT_L(0); PG8_MMA(0, 0, At, B0); PG8_BAR; PG8_SCHED;
            PG8_LDB(B1, 0, 1); PG8_STAGE(PG8_SB(0, 0), b2, voffB);
            PG8_BAR; PG8_WAIT_L(0); PG8_MMA(0, 1, At, B1); PG8_BAR;
            PG8_LDA(At, 0, 1); PG8_STAGE(PG8_SA(0, 0), a2, voffA);
            PG8_BAR; PG8_WAIT_L(0); PG8_MMA(1, 0, At, B0); PG8_BAR; PG8_SCHED;
            PG8_STAGE(PG8_SB(0, 1), b2 + hstepB, voffB);
            PG8_WAIT_V(6); PG8_BAR; PG8_MMA(1, 1, At, B1); PG8_BAR;
            PG8_LDB(B0, 1, 0); PG8_SCHED; PG8_LDA(At, 1, 0); PG8_STAGE(PG8_SA(0, 1), a2 + hstepA, voffA);
            PG8_WAIT_L(8); PG8_BAR; PG8_WAIT_L(0); PG8_MMA(0, 0, At, B0); PG8_BAR; PG8_SCHED;
            PG8_LDB(B1, 1, 1); PG8_STAGE(PG8_SB(1, 0), b3, voffB);
            PG8_BAR; PG8_WAIT_L(0); PG8_MMA(0, 1, At, B1); PG8_BAR;
            PG8_LDA(At, 1, 1); PG8_STAGE(PG8_SA(1, 0), a3, voffA);
            PG8_BAR; PG8_WAIT_L(0); PG8_MMA(1, 0, At, B0); PG8_BAR; PG8_SCHED;
            PG8_STAGE(PG8_SB(1, 1), b3 + hstepB, voffB);
            PG8_WAIT_V(6); PG8_BAR; PG8_MMA(1, 1, At, B1); PG8_BAR;
            }
        }
        if constexpr (ALIGN_EPI) { if (wr == 0) PG8_BAR; }
        if constexpr (!Epi::AFTER_DRAIN) { E(acc, cur, wr, wc, fr, fq); S.done(cur); }
        if (!has_next) break;
#pragma unroll
        for (int a = 0; a < 2; ++a)
#pragma unroll
            for (int b = 0; b < 2; ++b)
#pragma unroll
                for (int m = 0; m < 4; ++m)
#pragma unroll
                    for (int n = 0; n < 2; ++n) acc[a][b][m][n] = (f32x4){0.f, 0.f, 0.f, 0.f};
        cur = nxt; cA = nA; cB = nB; ++ui;
        if constexpr (ALIGN_EPI) { if (wr == 1) PG8_BAR; }
    }
    PG8_WAIT_V(0);
    if constexpr (!ALIGN_EPI) { if (wr == 0) PG8_BAR; }
    PG8_BAR;
    if constexpr (Epi::AFTER_DRAIN) { E.fused(acc, cur, wr, wc, fr, fq, lds, wid, lane); S.done(cur); }
#undef PG8_SA
#undef PG8_SB
#undef PG8_STAGE
#undef PG8_LDA
#undef PG8_LDB
#undef PG8_MMA
#undef PG8_WAIT_V
#undef PG8_WAIT_L
#undef PG8_BAR
#undef PG8_SCHED
}
}
#define GAS __attribute__((address_space(1)))
#define LAS __attribute__((address_space(3)))
typedef unsigned short bf16;
typedef unsigned v4u __attribute__((ext_vector_type(4)));
typedef float f32x4 __attribute__((ext_vector_type(4)));
typedef short bf16x8 __attribute__((ext_vector_type(8)));
typedef GAS unsigned gu32;
typedef GAS unsigned long long gu64;
#define RLX_AGENT __ATOMIC_RELAXED, __HIP_MEMORY_SCOPE_AGENT
#define LDS_WAIT() asm volatile("s_waitcnt lgkmcnt(0)" ::: "memory")
#define VM_WAIT() asm volatile("s_waitcnt vmcnt(0)" ::: "memory")
__device__ __forceinline__ unsigned long long rt() { return __builtin_amdgcn_s_memrealtime(); }
__device__ __forceinline__ unsigned f2bf(float f) { unsigned u = __builtin_bit_cast(unsigned, f); return (u + 0x7fffu + ((u >> 16) & 1u)) >> 16; }
__device__ __forceinline__ unsigned pk2(float lo, float hi) { return pg8::cvt_pk_bf16(lo, hi); }

#define XB_TMO      128
#define XB_XCNT(j)  (256  + 64 * (j))
#define XB_XSUB(j)  (1280 + 64 * (j))
#define XB_XGEN(j)  (2304 + 64 * (j))
#define XB_TOP      3328
#define XB_TOPGEN   3392
#define XCD_BAR_WORDS 3456
#define XB_SPIN_CAP (1u << 18)

__device__ __forceinline__ unsigned xb_ld(unsigned* p)              { return __hip_atomic_load(p, __ATOMIC_RELAXED, __HIP_MEMORY_SCOPE_AGENT); }
__device__ __forceinline__ unsigned xb_add(unsigned* p, unsigned v) { return __hip_atomic_fetch_add(p, v, __ATOMIC_RELAXED, __HIP_MEMORY_SCOPE_AGENT); }
__device__ __forceinline__ unsigned xb_xcc_id() { return (unsigned)__builtin_amdgcn_s_getreg((3 << 11) | 20) & 0xFu; }
#define XB_SPIN(cond, bar) do { unsigned _sp = 0; while (cond) { __builtin_amdgcn_s_sleep(1); \
    if ((++_sp & 255u) == 0u) { if (xb_ld(&(bar)[XB_TMO])) break; if (_sp > XB_SPIN_CAP) { atomicAdd(&(bar)[XB_TMO], 1u); break; } } } } while (0)

struct XcdBarrier {
    unsigned* bar; unsigned x;
    volatile LAS unsigned* st;
};

__device__ __forceinline__ XcdBarrier xcd_barrier_post(unsigned* bar, volatile LAS unsigned* st) {
    XcdBarrier b; b.bar = bar; b.x = xb_xcc_id(); b.st = st;
    if (threadIdx.x == 0) (void)xb_add(&bar[XB_XCNT(b.x)], 1u);
    return b;
}
__device__ __forceinline__ void xcd_barrier_complete(unsigned* bar, unsigned x, unsigned& nloc, unsigned& nx) {
    const unsigned G = gridDim.x * gridDim.y * gridDim.z;
    unsigned sum, cnt, mine, sp = 0u;
    for (;;) {
        sum = 0u; cnt = 0u; mine = 0u;
#pragma unroll
        for (unsigned j = 0; j < 16; ++j) { const unsigned c = xb_ld(&bar[XB_XCNT(j)]); sum += c; cnt += (c > 0u) ? 1u : 0u; mine = (j == x) ? c : mine; }
        if (sum == G) break;
        __builtin_amdgcn_s_sleep(1);
        if ((++sp & 255u) == 0u) { if (xb_ld(&bar[XB_TMO])) break; if (sp > XB_SPIN_CAP) { atomicAdd(&bar[XB_TMO], 1u); break; } }
    }
    nloc = mine > 0u ? mine : 1u; nx = cnt > 0u ? cnt : 1u;
}

__device__ __forceinline__ void xcd_barrier(const XcdBarrier& b) {
    asm volatile("s_waitcnt vmcnt(0)" ::: "memory");
    __syncthreads();
    if (threadIdx.x == 0) {
        unsigned* bar = b.bar;
        __builtin_amdgcn_s_waitcnt(0);
        unsigned nloc = b.st[0], nx = b.st[1];
        if (nloc == 0u) { xcd_barrier_complete(bar, b.x, nloc, nx); b.st[0] = nloc; b.st[1] = nx; }
        const unsigned old = xb_add(&bar[XB_XSUB(b.x)], 1u);
        const unsigned gen = old / nloc;
        if (old + 1u == (gen + 1u) * nloc) {
            __builtin_amdgcn_fence(__ATOMIC_RELEASE, "agent");
            asm volatile("s_waitcnt vmcnt(0)" ::: "memory");
            const unsigned og = xb_add(&bar[XB_TOP], 1u);
            const unsigned tg = og / nx;
            if (og + 1u == (tg + 1u) * nx) xb_add(&bar[XB_TOPGEN], 1u);
            else XB_SPIN(xb_ld(&bar[XB_TOPGEN]) == tg, bar);
            __builtin_amdgcn_fence(__ATOMIC_ACQUIRE, "agent");
            xb_add(&bar[XB_XGEN(b.x)], 1u);
            asm volatile("s_waitcnt vmcnt(0)" ::: "memory");
        } else {
            XB_SPIN(xb_ld(&bar[XB_XGEN(b.x)]) == gen, bar);
            __builtin_amdgcn_fence(__ATOMIC_ACQUIRE, "agent");
            asm volatile("s_waitcnt vmcnt(0)" ::: "memory");
        }
    }
    __syncthreads();
}


constexpr int NWAVES = 8;
constexpr int D = 2048, MP = 8192, MS = 1024, M = MP + MS;
constexpr int NSQ = 128, LS = 8;
constexpr int NH = 4, DK = 256, DV = 512, DQK = 1024;
constexpr int NIN = 11280, NINP = 11520, DFF = 5632, NGU = 11264, DPOOL = 1024, NADA = 12288, NMOD = 2 * NADA;
constexpr int C_Q = 0, C_K = 1024, C_V = 2048, C_OG = 4096, C_U = 6144, C_GA = 7168, C_GB = 9216, C_ALR = 11264;
constexpr float EPS = 1e-6f;
constexpr size_t PL = (size_t)M * 256;
#define P_Q(row, h) ((size_t)(h) * PL + (size_t)(row) * 256)
#define P_K(row, h) ((size_t)(4 + (h)) * PL + (size_t)(row) * 256)
#define P_V(row, h) ((size_t)(8 + 2 * (h)) * PL + (size_t)(row) * 512)
#define P_OG(row, h) ((size_t)(16 + 2 * (h)) * PL + (size_t)(row) * 512)
#define P_U(row, g) ((size_t)(24 + (g)) * PL + (size_t)(row) * 256)
#define P_GA(row, h) ((size_t)(28 + 2 * (h)) * PL + (size_t)(row) * 512)
#define P_GB(row, h) ((size_t)(36 + 2 * (h)) * PL + (size_t)(row) * 512)
#define P_ALR(row) ((size_t)44 * PL + (size_t)(row) * 256)
constexpr size_t OUT_Y = 0, OUT_GLAP = (size_t)M * D, OUT_POOLP = OUT_GLAP + 2ull * 4 * 4 * 256 * 512, OUT_GLAS = OUT_POOLP + 2ull * 4 * 15 * 1024,
                 OUT_POOLS = OUT_GLAS + 2ull * 128 * 4 * 256 * 512, OUT_END = OUT_POOLS + 2ull * 128 * 15 * 1024;
constexpr size_t MiB = 1u << 20;
constexpr size_t WS_CTL = 0, CTL_ZERO_BYTES = 64 * 1024;
constexpr size_t WS_WADA = 1 * MiB;
constexpr size_t WS_WIN = WS_WADA + 96 * MiB;
constexpr size_t WS_WO = WS_WIN + 2 * 45 * MiB;
constexpr size_t WS_WGU = WS_WO + 2 * 8 * MiB;
constexpr size_t WS_WDN = WS_WGU + 2 * 44 * MiB;
constexpr size_t WS_WPL = WS_WDN + 2 * 22 * MiB;
constexpr size_t WS_AC = WS_WPL + 2 * 1 * MiB;
constexpr size_t WS_MOD = WS_AC + 1 * MiB;
constexpr size_t WS_XN = WS_MOD + 24 * MiB;
constexpr size_t WS_P = WS_XN + 36 * MiB;
constexpr size_t WS_QE = WS_P + 203 * MiB;
constexpr size_t WS_KDT = WS_QE + 16 * MiB;
constexpr size_t WS_VT = WS_KDT + 16 * MiB;
constexpr size_t WS_ATT = WS_VT + 32 * MiB;
constexpr size_t WS_DEC = WS_ATT + 4 * MiB;
constexpr size_t WS_QES = WS_DEC + 1 * MiB;
constexpr size_t WS_KDS = WS_QES + 4 * MiB;
constexpr size_t WS_DECS = WS_KDS + 4 * MiB;
constexpr size_t WS_ATTS = WS_DECS + 1 * MiB;
constexpr size_t WS_DM = WS_ATTS + 1 * MiB;
constexpr size_t WS_O = WS_DM + 18 * MiB;
constexpr size_t WS_YB = WS_O + 36 * MiB;
constexpr size_t WS_MG = WS_YB + 36 * MiB;
constexpr size_t WS_X1 = WS_MG + 36 * MiB;
constexpr size_t WS_X2 = WS_X1 + 72 * MiB;
constexpr size_t WS_ACT = WS_X2 + 72 * MiB;
constexpr size_t WS_SLAB = WS_ACT + 99 * MiB;
constexpr size_t WS_END = WS_SLAB + 64 * MiB;
constexpr int CW_GLAQ = 2048;
constexpr int CW_BAR = 4096;
static_assert((CW_BAR + XCD_BAR_WORDS) * 4 <= (int)CTL_ZERO_BYTES && (CW_GLAQ + 128) * 4 <= (int)CTL_ZERO_BYTES, "CTL");
constexpr int LDS_BYTES = 163840;
constexpr int MISC_OFF = LDS_BYTES - 256;

struct Frame {
    LAS unsigned char* lds; volatile LAS unsigned* MISC; gu32* ctl;
    int tid, lane, wave, vcu, G;
    const float *xP, *xS, *stG, *stP, *cP, *cS, *w_ada, *b_ada, *norm1_g, *w_in, *w_a2, *b_a, *gla_norm_g, *w_pool, *pool_scale, *w_o, *norm2_g, *w_gu, *w_down, *final_g;
    float* out; unsigned char* ws;
};
__device__ __forceinline__ float wave_sum(float v) {
#pragma unroll
    for (int o = 1; o < 64; o <<= 1) v += __shfl_xor(v, o);
    return v;
}
__device__ __forceinline__ float bf2f(unsigned short b) { return __builtin_bit_cast(float, (unsigned)b << 16); }
__device__ __forceinline__ float bflo(unsigned w) { return __builtin_bit_cast(float, w << 16); }
__device__ __forceinline__ float bfhi(unsigned w) { return __builtin_bit_cast(float, w & 0xffff0000u); }
__device__ __forceinline__ float sigmoidf_(float x) { return 1.0f / (1.0f + __expf(-x)); }
__device__ __forceinline__ int seq_of_row(int r) { return r < MP ? (r >> 11) : 4 + ((r - MP) >> 3); }

template <int MODE>
__device__ __forceinline__ void conv_tile_ld(const float* W, int Nsrc, int k0, int n0, int lane, f32x4 (&v)[8]) {
    const int c = lane & 15, g = lane >> 4, n = n0 + 4 * c;
    const bool ok = n < Nsrc;
#pragma unroll
    for (int j = 0; j < 8; ++j) v[j] = ok ? *(const GAS f32x4*)(W + (size_t)(k0 + 8 * g + j) * Nsrc + n) : (f32x4){0.f, 0.f, 0.f, 0.f};
}
template <int MODE>
__device__ __forceinline__ void conv_tile_st(bf16* WT, int ldk, int k0, int n0, int lane, const f32x4 (&v)[8]) {
    const int c = lane & 15, g = lane >> 4, n = n0 + 4 * c;
    int dr = n;
    if (MODE == 1) dr = (n < DFF) ? 256 * (n >> 7) + (n & 127) : 256 * ((n - DFF) >> 7) + 128 + ((n - DFF) & 127);
#pragma unroll
    for (int i = 0; i < 4; ++i) { v4u o; o.x = pk2(v[0][i], v[1][i]); o.y = pk2(v[2][i], v[3][i]); o.z = pk2(v[4][i], v[5][i]); o.w = pk2(v[6][i], v[7][i]);
        *(GAS v4u*)(WT + (size_t)(dr + i) * ldk + k0 + 8 * g) = o; }
}
template <int MODE>
__device__ __forceinline__ void conv_matrix(const float* W, int K, int Nsrc, int Npad, bf16* WT, int gw, int NGW, int lane) {
    const int nb = Npad / 64, ntile = (K / 32) * nb;
    f32x4 va[8], vb[8], vc[8];
    int t = gw;
    if (t < ntile) conv_tile_ld<MODE>(W, Nsrc, (t / nb) * 32, (t % nb) * 64, lane, va);
    if (t + NGW < ntile) conv_tile_ld<MODE>(W, Nsrc, ((t + NGW) / nb) * 32, ((t + NGW) % nb) * 64, lane, vb);
#pragma unroll 1
    for (; t < ntile; t += 3 * NGW) {
        const int t1 = t + NGW, t2 = t + 2 * NGW, t3 = t + 3 * NGW, t4 = t + 4 * NGW;
        if (t2 < ntile) conv_tile_ld<MODE>(W, Nsrc, (t2 / nb) * 32, (t2 % nb) * 64, lane, vc);
        conv_tile_st<MODE>(WT, K, (t / nb) * 32, (t % nb) * 64, lane, va);
        if (t3 < ntile) conv_tile_ld<MODE>(W, Nsrc, (t3 / nb) * 32, (t3 % nb) * 64, lane, va);
        if (t1 < ntile) conv_tile_st<MODE>(WT, K, (t1 / nb) * 32, (t1 % nb) * 64, lane, vb);
        if (t4 < ntile) conv_tile_ld<MODE>(W, Nsrc, (t4 / nb) * 32, (t4 % nb) * 64, lane, vb);
        if (t2 < ntile) conv_tile_st<MODE>(WT, K, (t2 / nb) * 32, (t2 % nb) * 64, lane, vc);
    }
}
enum { CV_ADA = 1, CV_IN = 2, CV_O = 4, CV_GU = 8, CV_DN = 16, CV_PL = 32 };
template <int WHICH>
__device__ __forceinline__ void conv_set(Frame& F, int l, int gw, int NGW) {
    unsigned char* ws = F.ws; const int lane = F.lane;
    if (WHICH & CV_ADA) conv_matrix<0>(F.w_ada + (size_t)l * D * NADA, D, NADA, NADA, (bf16*)(ws + WS_WADA) + (size_t)l * NADA * D, gw, NGW, lane);
    if (WHICH & CV_IN) conv_matrix<0>(F.w_in + (size_t)l * D * NIN, D, NIN, NINP, (bf16*)(ws + WS_WIN + (size_t)l * 45 * MiB), gw, NGW, lane);
    if (WHICH & CV_PL) {
#pragma unroll 1
        for (int g = 0; g < 4; ++g)
            conv_matrix<0>(F.w_pool + (size_t)(l * 4 + g) * 256 * 512, 256, 512, 512, (bf16*)(ws + WS_WPL + (size_t)l * 1 * MiB) + (size_t)g * 512 * 256, gw, NGW, lane);
    }
    if (WHICH & CV_O) conv_matrix<0>(F.w_o + (size_t)l * D * D, D, D, D, (bf16*)(ws + WS_WO + (size_t)l * 8 * MiB), gw, NGW, lane);
    if (WHICH & CV_GU) conv_matrix<1>(F.w_gu + (size_t)l * D * NGU, D, NGU, NGU, (bf16*)(ws + WS_WGU + (size_t)l * 44 * MiB), gw, NGW, lane);
    if (WHICH & CV_DN) conv_matrix<0>(F.w_down + (size_t)l * DFF * D, DFF, D, D, (bf16*)(ws + WS_WDN + (size_t)l * 22 * MiB), gw, NGW, lane);
}
template <int WHICH>
__device__ __forceinline__ void conv_in_tail(Frame& F, int l, int nwg) {
    const int R = nwg % F.G, c = (int)blockIdx.x;
    if (c >= R) conv_set<WHICH>(F, l, (c - R) * NWAVES + F.wave, (F.G - R) * NWAVES);
}
__device__ __forceinline__ void p0_convert(Frame& F) {
    unsigned char* ws = F.ws;
    bf16* AC = (bf16*)(ws + WS_AC);
    for (int i = (F.vcu * NWAVES * 64 + F.tid); i < 256 * D / 2; i += F.G * NWAVES * 64) {
        const int r = (2 * i) / D, c = (2 * i) % D; float a = 0.f, b = 0.f;
        if (r < 132) { const float* src = r < 4 ? F.cP + (size_t)r * D + c : F.cS + (size_t)(r - 4) * D + c; a = src[0]; b = src[1]; a = a * sigmoidf_(a); b = b * sigmoidf_(b); }
        *(GAS unsigned*)(AC + 2 * (size_t)i) = pk2(a, b);
    }
}
__device__ __forceinline__ void ada_direct(Frame& F) {
    const int cu = (int)blockIdx.x;
    if (cu >= 192) return;
    const bf16* AC = (const bf16*)(F.ws + WS_AC); float* MOD = (float*)(F.ws + WS_MOD);
    const int lane = F.lane, wave = F.wave, c = lane & 15, g = lane >> 4;
    const int ng = cu * 2 + (wave & 1), kh = (wave >> 1) & 1, mh = wave >> 2, l = ng / 192, n0 = (ng % 192) * 64;
    const float* W = F.w_ada + (size_t)l * D * NADA + n0 + 4 * c + (size_t)(kh * 1024 + 8 * g) * NADA;
    const bf16* Ap = AC + (size_t)(80 * mh + c) * D + kh * 1024 + 8 * g;
    f32x4 acc[5][4];
#pragma unroll
    for (int mt = 0; mt < 5; ++mt)
#pragma unroll
        for (int i = 0; i < 4; ++i) acc[mt][i] = (f32x4){0.f, 0.f, 0.f, 0.f};
    f32x4 v[8], vn[8];
#pragma unroll
    for (int j = 0; j < 8; ++j) v[j] = *(const GAS f32x4*)(W + (size_t)j * NADA);
#pragma unroll 1
    for (int ks = 0; ks < 32; ++ks) {
        if (ks + 1 < 32) {
#pragma unroll
            for (int j = 0; j < 8; ++j) vn[j] = *(const GAS f32x4*)(W + (size_t)(32 * (ks + 1) + j) * NADA); }
        bf16x8 Bf[4];
#pragma unroll
        for (int i = 0; i < 4; ++i) { const v4u pk = {pk2(v[0][i], v[1][i]), pk2(v[2][i], v[3][i]), pk2(v[4][i], v[5][i]), pk2(v[6][i], v[7][i])}; Bf[i] = __builtin_bit_cast(bf16x8, pk); }
#pragma unroll
        for (int mt = 0; mt < 5; ++mt) { const bf16x8 Af = *(const GAS bf16x8*)(Ap + (size_t)mt * 16 * D + 32 * ks);
#pragma unroll
            for (int i = 0; i < 4; ++i) acc[mt][i] = __builtin_amdgcn_mfma_f32_16x16x32_bf16(Af, Bf[i], acc[mt][i], 0, 0, 0); }
        if (ks + 1 < 32) {
#pragma unroll
            for (int j = 0; j < 8; ++j) v[j] = vn[j]; }
    }
    LAS float* red = (LAS float*)F.lds + ((wave & 1) + 2 * mh) * (80 * 64);
    if (kh == 1) {
#pragma unroll
        for (int mt = 0; mt < 5; ++mt)
#pragma unroll
            for (int i = 0; i < 4; ++i)
#pragma unroll
                for (int r = 0; r < 4; ++r) red[((mt * 4 + i) * 4 + r) * 64 + lane] = acc[mt][i][r]; }
    __syncthreads();
    if (kh == 0) {
        const f32x4 bias = *(const GAS f32x4*)(F.b_ada + (size_t)l * NADA + n0 + 4 * c);
#pragma unroll
        for (int mt = 0; mt < 5; ++mt)
#pragma unroll
            for (int r = 0; r < 4; ++r) { f32x4 o;
#pragma unroll
                for (int i = 0; i < 4; ++i) o[i] = acc[mt][i][r] + red[((mt * 4 + i) * 4 + r) * 64 + lane] + bias[i];
                *(GAS f32x4*)(MOD + (size_t)(80 * mh + 16 * mt + 4 * g + r) * NMOD + (size_t)l * NADA + n0 + 4 * c) = o; }
    }
    __syncthreads();
}
__device__ __forceinline__ void norm_rows(Frame& F, const float* srcP, const float* srcS, const float* gain, const float* sh_base  , bf16* XN,
                                          const bf16* rslab, const float* rbase, const float* rgate, float* xout) {
    const int gw = F.vcu * NWAVES + F.wave, NGW = F.G * NWAVES;
    f32x4 vn[8];
    { const int r = gw; if (r < M && !(rslab != nullptr && r >= MP)) { const GAS f32x4* xr = (const GAS f32x4*)(r < MP ? srcP + (size_t)r * D : srcS + (size_t)(r - MP) * D) + F.lane;
#pragma unroll
        for (int j = 0; j < 8; ++j) vn[j] = xr[64 * j]; } }
    for (int r = gw; r < M; r += NGW) {
        f32x4 v[8]; float s = 0.f;
        if (rslab != nullptr && r >= MP) {
            const GAS f32x4* bp = (const GAS f32x4*)(rbase + (size_t)(r - MP) * D) + F.lane; const GAS f32x4* gp = (const GAS f32x4*)(rgate + (size_t)seq_of_row(r) * NMOD) + F.lane;
            GAS f32x4* xo = (GAS f32x4*)(xout + (size_t)r * D) + F.lane;
#pragma unroll
            for (int j = 0; j < 8; ++j) { f32x4 a = {0.f, 0.f, 0.f, 0.f};
#pragma unroll
                for (int sl = 0; sl < 8; ++sl) { typedef unsigned u32x2 __attribute__((ext_vector_type(2))); const u32x2 w = *((const GAS u32x2*)(rslab + ((size_t)sl * MS + (r - MP)) * D) + F.lane + 64 * j); a += (f32x4){bflo(w.x), bfhi(w.x), bflo(w.y), bfhi(w.y)}; }
                v[j] = bp[64 * j] + gp[64 * j] * a; xo[64 * j] = v[j]; if (j & 1) asm volatile("" ::: "memory"); }
        } else {
#pragma unroll
            for (int j = 0; j < 8; ++j) v[j] = vn[j];
        }
        { const int rn = r + NGW; if (rn < M && !(rslab != nullptr && rn >= MP)) { const GAS f32x4* xr = (const GAS f32x4*)(rn < MP ? srcP + (size_t)rn * D : srcS + (size_t)(rn - MP) * D) + F.lane;
#pragma unroll
            for (int j = 0; j < 8; ++j) vn[j] = xr[64 * j]; } }
#pragma unroll
        for (int j = 0; j < 8; ++j) s += (v[j].x * v[j].x + v[j].y * v[j].y) + (v[j].z * v[j].z + v[j].w * v[j].w);
        const float rstd = 1.0f / sqrtf(wave_sum(s) * (1.0f / D) + EPS);
        const float* sh = sh_base + (size_t)seq_of_row(r) * NMOD; const float* sc = sh + D;
        GAS unsigned long long* o8 = (GAS unsigned long long*)(XN + (size_t)r * D) + F.lane;
#pragma unroll
        for (int j = 0; j < 8; ++j) { const int c = 4 * (F.lane + 64 * j);
            const f32x4 g4 = *(const GAS f32x4*)(gain + c), s4 = *(const GAS f32x4*)(sh + c), c4 = *(const GAS f32x4*)(sc + c);
            const f32x4 o = v[j] * rstd * g4 * (c4 + 1.0f) + s4;
            o8[64 * j] = (unsigned long long)pk2(o.x, o.y) | ((unsigned long long)pk2(o.z, o.w) << 32); }
    }
}
__device__ __forceinline__ void final_norm(Frame& F, const float* src, const bf16* rslab, const float* rbase, const float* rgate) {
    const int gw = F.vcu * NWAVES + F.wave, NGW = F.G * NWAVES;
    for (int r = gw; r < M; r += NGW) {
        f32x4 v[8]; float s = 0.f;
        if (r >= MP) {
            const GAS f32x4* bp = (const GAS f32x4*)(rbase + (size_t)(r - MP) * D) + F.lane; const GAS f32x4* gp = (const GAS f32x4*)(rgate + (size_t)seq_of_row(r) * NMOD) + F.lane;
#pragma unroll
            for (int j = 0; j < 8; ++j) { f32x4 a = {0.f, 0.f, 0.f, 0.f};
#pragma unroll
                for (int sl = 0; sl < 8; ++sl) { typedef unsigned u32x2 __attribute__((ext_vector_type(2))); const u32x2 w = *((const GAS u32x2*)(rslab + ((size_t)sl * MS + (r - MP)) * D) + F.lane + 64 * j); a += (f32x4){bflo(w.x), bfhi(w.x), bflo(w.y), bfhi(w.y)}; }
                v[j] = bp[64 * j] + gp[64 * j] * a; if (j & 1) asm volatile("" ::: "memory"); }
        } else {
            const GAS f32x4* xr = (const GAS f32x4*)(src + (size_t)r * D) + F.lane;
#pragma unroll
            for (int j = 0; j < 8; ++j) v[j] = xr[64 * j];
        }
#pragma unroll
        for (int j = 0; j < 8; ++j) s += (v[j].x * v[j].x + v[j].y * v[j].y) + (v[j].z * v[j].z + v[j].w * v[j].w);
        const float rstd = 1.0f / sqrtf(wave_sum(s) * (1.0f / D) + EPS);
        GAS f32x4* o = (GAS f32x4*)(F.out + OUT_Y + (size_t)r * D) + F.lane;
#pragma unroll
        for (int j = 0; j < 8; ++j) { const f32x4 g4 = *(const GAS f32x4*)(F.final_g + 4 * (F.lane + 64 * j)); o[64 * j] = v[j] * rstd * g4; }
    }
}
__device__ __forceinline__ float logsigmoid_(float x) { return fminf(x, 0.f) - __logf(1.0f + __expf(-fabsf(x))); }
__device__ __forceinline__ void prep_phase(Frame& F, int l) {
    unsigned char* ws = F.ws;
    const bf16* P = (const bf16*)(ws + WS_P);
    bf16* QE = (bf16*)(ws + WS_QE); bf16* KDT = (bf16*)(ws + WS_KDT); bf16* VT = (bf16*)(ws + WS_VT); bf16* ATT = (bf16*)(ws + WS_ATT);
    float* DEC = (float*)(ws + WS_DEC); float* QES = (float*)(ws + WS_QES); float* KDS = (float*)(ws + WS_KDS); float* DECS = (float*)(ws + WS_DECS); float* ATTS = (float*)(ws + WS_ATTS);
    bf16* DM = (bf16*)(ws + WS_DM);
    LAS float* ALR = (LAS float*)(F.lds);
    LAS float* TOT = (LAS float*)(F.lds + 4096);
    LAS unsigned char* QEl = F.lds + 8192;
    LAS unsigned char* KEl = F.lds + 8192 + 33792;
    LAS unsigned char* Vl = F.lds + 8192;
    const int tid = F.tid, lane = F.lane, wave = F.wave, dk = tid & 255, hf = tid >> 8;
    for (int item = (int)blockIdx.x; item < 144 * 4; item += F.G) {
        const int rb = item >> 2, h = item & 3, r0 = rb * 64; const bool isS = rb >= 128;
        const int bseq = rb >> 5, tseq0 = (rb & 31) * 64;
        { const int t = tid >> 3, j2 = (tid & 7) * 2; const unsigned w = *(const GAS unsigned*)(P + P_ALR(r0 + t) + j2); ALR[t * 16 + j2] = bflo(w); ALR[t * 16 + j2 + 1] = bfhi(w); }
        float wcol[16];
#pragma unroll
        for (int j = 0; j < 16; ++j) wcol[j] = F.w_a2[(size_t)(l * 16 + j) * DQK + h * DK + dk];
        const float ba = F.b_a[(size_t)l * DQK + h * DK + dk];
        __syncthreads();
        float la[32];
#pragma unroll
        for (int tt = 0; tt < 32; ++tt) { const int t = 32 * hf + tt; float a = ba;
#pragma unroll
            for (int j4 = 0; j4 < 4; ++j4) { const f32x4 x = *(const LAS f32x4*)(ALR + t * 16 + 4 * j4); a += x.x * wcol[4 * j4] + x.y * wcol[4 * j4 + 1] + x.z * wcol[4 * j4 + 2] + x.w * wcol[4 * j4 + 3]; }
            la[tt] = logsigmoid_(a) * 0.0625f; }
        if (!isS) { float run = 0.f;
#pragma unroll
            for (int tt = 0; tt < 32; ++tt) { run += la[tt]; la[tt] = run; }
            TOT[hf * 256 + dk] = run;
        } else { float run = 0.f;
#pragma unroll
            for (int tt = 0; tt < 32; ++tt) { run = (tt & 7) ? run + la[tt] : la[tt]; la[tt] = run; } }
        __syncthreads();
        float off = 0.f, blast = 0.f;
        if (!isS) { const float t0 = TOT[dk], t1 = TOT[256 + dk]; off = hf ? t0 : 0.f; blast = t0 + t1; }
        unsigned kdp[16], qk[32];
#pragma unroll
        for (int tt = 0; tt < 32; ++tt) { const int rw = r0 + 32 * hf + tt; qk[tt] = (unsigned)P[P_Q(rw, h) + dk] | ((unsigned)P[P_K(rw, h) + dk] << 16); }
#pragma unroll
        for (int tt = 0; tt < 32; ++tt) { const int t = 32 * hf + tt, row = r0 + t;
            const float q = bflo(qk[tt]), k = bfhi(qk[tt]);
            const float b = la[tt] + off, bl = isS ? la[tt | 7] : blast;
            const float qe = q * 0.0625f * __expf(b), ke = k * __expf(-b), kd = k * __expf(bl - b);
            const unsigned short qb = (unsigned short)f2bf(qe), kb = (unsigned short)f2bf(ke);
            *(LAS unsigned short*)(QEl + t * 528 + dk * 2) = qb; *(LAS unsigned short*)(KEl + t * 528 + dk * 2) = kb;
            if (!isS) { QE[(size_t)row * DQK + h * DK + dk] = qb; const unsigned kdb = f2bf(kd); if (tt & 1) kdp[tt >> 1] |= kdb << 16; else kdp[tt >> 1] = kdb; }
            else { QES[(size_t)(row - MP) * DQK + h * DK + dk] = qe; KDS[(size_t)(row - MP) * DQK + h * DK + dk] = kd; } }
        if (!isS) {
            GAS v4u* dst = (GAS v4u*)(KDT + ((size_t)((bseq * 4 + h) * DK + dk)) * 2048 + tseq0 + 32 * hf);
#pragma unroll
            for (int i = 0; i < 4; ++i) dst[i] = (v4u){kdp[4 * i], kdp[4 * i + 1], kdp[4 * i + 2], kdp[4 * i + 3]};
            if (hf == 0) DEC[(size_t)(rb * 4 + h) * DK + dk] = __expf(blast);
        } else {
#pragma unroll
            for (int sg = 0; sg < 4; ++sg) DECS[(size_t)((rb - 128) * 8 + 4 * hf + sg) * DQK + h * DK + dk] = __expf(la[8 * sg + 7]);
        }
        __syncthreads();
        { const int mt = wave >> 1, nt0 = (wave & 1) * 2, c = lane & 15, g = lane >> 4;
            f32x4 a0 = {0.f, 0.f, 0.f, 0.f}, a1 = {0.f, 0.f, 0.f, 0.f};
#pragma unroll
            for (int kk = 0; kk < 8; ++kk) {
                const bf16x8 A = *(const LAS bf16x8*)(QEl + (16 * mt + c) * 528 + (32 * kk + 8 * g) * 2);
                const bf16x8 B0 = *(const LAS bf16x8*)(KEl + (16 * nt0 + c) * 528 + (32 * kk + 8 * g) * 2);
                const bf16x8 B1 = *(const LAS bf16x8*)(KEl + (16 * (nt0 + 1) + c) * 528 + (32 * kk + 8 * g) * 2);
                a0 = __builtin_amdgcn_mfma_f32_16x16x32_bf16(A, B0, a0, 0, 0, 0); a1 = __builtin_amdgcn_mfma_f32_16x16x32_bf16(A, B1, a1, 0, 0, 0); }
#pragma unroll
            for (int q = 0; q < 2; ++q) { const f32x4 a = q ? a1 : a0; const int s = 16 * (nt0 + q) + c;
#pragma unroll
                for (int i = 0; i < 4; ++i) { const int t = 16 * mt + 4 * g + i; const float v = (s <= t) ? a[i] : 0.f;
                    if (!isS) ATT[((size_t)(rb * 4 + h) * 64 + t) * 64 + s] = (unsigned short)f2bf(v);
                    else if ((t >> 3) == (s >> 3)) ATTS[(((size_t)((rb - 128) * 8 + (t >> 3)) * 4 + h) * 8 + (t & 7)) * 8 + (s & 7)] = v; } }
        }
        if (!isS) {
            __syncthreads();
#pragma unroll
            for (int i = 0; i < 8; ++i) { const int idx = i * 512 + tid, t = idx >> 6, ch = idx & 63;
                const v4u w = *(const GAS v4u*)(P + P_V(r0 + t, h) + ch * 8); *(LAS v4u*)(Vl + t * 1040 + ch * 16) = w; }
            __syncthreads();
            GAS v4u* dst = (GAS v4u*)(VT + ((size_t)((bseq * 4 + h) * DV + tid)) * 2048 + tseq0);
#pragma unroll
            for (int t8 = 0; t8 < 8; ++t8) { unsigned wd[4];
#pragma unroll
                for (int j = 0; j < 4; ++j) { const unsigned lo = *(const LAS unsigned short*)(Vl + (8 * t8 + 2 * j) * 1040 + tid * 2), hi = *(const LAS unsigned short*)(Vl + (8 * t8 + 2 * j + 1) * 1040 + tid * 2); wd[j] = lo | (hi << 16); }
                dst[t8] = (v4u){wd[0], wd[1], wd[2], wd[3]}; }
        }
        __syncthreads();
    }
}
template <int W>
__device__ __forceinline__ void pool_block(Frame& F, int l, int rblk, int g, int lane) {
    typedef unsigned u32x2 __attribute__((ext_vector_type(2)));
    const bf16* P = (const bf16*)(F.ws + WS_P); bf16* DM = (bf16*)(F.ws + WS_DM);
    const int r0 = rblk * 16, ch = 4 * lane;
    const float rw = 1.0f / (float)W;
    if (r0 < MP) {
        const int tq0 = r0 & 2047;
        u32x2 x[15 + W];
#pragma unroll
        for (int i = 0; i < 15 + W; ++i) { const int rr = r0 - (W - 1) + i; x[i] = (tq0 - (W - 1) + i >= 0) ? *(const GAS u32x2*)(P + P_U(rr, g) + ch) : (u32x2){0u, 0u}; }
        float s0 = 0.f, s1 = 0.f, s2 = 0.f, s3 = 0.f;
#pragma unroll
        for (int i = 0; i < W - 1; ++i) { s0 += bflo(x[i].x); s1 += bfhi(x[i].x); s2 += bflo(x[i].y); s3 += bfhi(x[i].y); }
#pragma unroll
        for (int i = 0; i < 16; ++i) { const u32x2 cu = x[i + W - 1]; const float u0 = bflo(cu.x), u1 = bfhi(cu.x), u2 = bflo(cu.y), u3 = bfhi(cu.y);
            s0 += u0; s1 += u1; s2 += u2; s3 += u3;
            const int tq = tq0 + i; const float rc = (tq + 1 >= W) ? rw : 1.0f / (float)(tq + 1);
            *(GAS u32x2*)(DM + (size_t)(r0 + i) * DPOOL + 256 * g + ch) = (u32x2){pk2(s0 * rc - u0, s1 * rc - u1), pk2(s2 * rc - u2, s3 * rc - u3)};
            const u32x2 ou = x[i]; s0 -= bflo(ou.x); s1 -= bfhi(ou.x); s2 -= bflo(ou.y); s3 -= bfhi(ou.y);
            if (tq >= 2033) *(GAS f32x4*)(F.out + OUT_POOLP + ((size_t)(l * 4 + (r0 >> 11)) * 15 + (tq - 2033)) * DPOOL + 256 * g + ch) = (f32x4){u0, u1, u2, u3}; }
    } else {
#pragma unroll
        for (int sq = 0; sq < 2; ++sq) { const int rs = r0 + 8 * sq, seq = (rs - MP) >> 3;
            const float* sp = F.stP + ((size_t)(l * NSQ + seq) * 15) * DPOOL + 256 * g + ch; float* op = F.out + OUT_POOLS + ((size_t)(l * NSQ + seq) * 15) * DPOOL + 256 * g + ch;
            f32x4 hst[15]; u32x2 x[8];
#pragma unroll
            for (int i = 0; i < 15; ++i) if (i >= 8 || i >= 15 - (W - 1)) hst[i] = *(const GAS f32x4*)(sp + (size_t)i * DPOOL);
#pragma unroll
            for (int i = 0; i < 8; ++i) x[i] = *(const GAS u32x2*)(P + P_U(rs + i, g) + ch);
#pragma unroll
            for (int i = 0; i < 7; ++i) *(GAS f32x4*)(op + (size_t)i * DPOOL) = hst[8 + i];
            f32x4 s = {0.f, 0.f, 0.f, 0.f};
#pragma unroll
            for (int i = 15 - (W - 1); i < 15; ++i) s += hst[i];
#pragma unroll
            for (int i = 0; i < 8; ++i) { const f32x4 u = {bflo(x[i].x), bfhi(x[i].x), bflo(x[i].y), bfhi(x[i].y)}; s += u;
                *(GAS u32x2*)(DM + (size_t)(rs + i) * DPOOL + 256 * g + ch) = (u32x2){pk2(s.x * rw - u.x, s.y * rw - u.y), pk2(s.z * rw - u.z, s.w * rw - u.w)};
                const int idx = 15 + i - (W - 1);
                if (idx >= 15) { const u32x2 ou = x[idx - 15 < 8 ? idx - 15 : 0]; s -= (f32x4){bflo(ou.x), bfhi(ou.x), bflo(ou.y), bfhi(ou.y)}; } else s -= hst[idx];
                *(GAS f32x4*)(op + (size_t)(7 + i) * DPOOL) = u; }
        }
    }
}
__device__ __forceinline__ void pool_rows(Frame& F, int l) {
    const int gw = F.vcu * NWAVES + F.wave, NGW = F.G * NWAVES, lane = F.lane;
#pragma unroll 1
    for (int it = gw; it < (M / 16) * 4; it += NGW) { const int g = it & 3, rblk = it >> 2;
        if (g == 0) pool_block<2>(F, l, rblk, 0, lane); else if (g == 1) pool_block<4>(F, l, rblk, 1, lane); else if (g == 2) pool_block<8>(F, l, rblk, 2, lane); else pool_block<16>(F, l, rblk, 3, lane);
    }
}
typedef float f32x16 __attribute__((ext_vector_type(16)));
constexpr int GQ_STR = 528, GK_STR = 144, GA_STR = 144, GBUF = 64 * GQ_STR + 256 * GK_STR + 64 * GA_STR + 1024;
static_assert(GBUF == 79 * 1024 && 2 * GBUF <= MISC_OFF, "gla LDS");
__device__ __forceinline__ void gla_stage_offsets(int hw, int lane, unsigned (&off)[20]) {
#pragma unroll
    for (int i = 0; i < 20; ++i) { const int p = hw + 4 * i, c = p * 64 + lane; unsigned o;
        if (p < 33) { const int row = c / 33, cc = c - row * 33; o = (unsigned)(row * DQK * 2 + (cc < 31 ? cc : 31) * 16); }
        else if (p < 69) { const int c2 = c - 33 * 64, row = c2 / 9, cc = c2 - row * 9; o = (unsigned)(row * 2048 * 2 + (cc < 7 ? cc : 7) * 16); }
        else if (p < 78) { const int c2 = c - 69 * 64, row = c2 / 9, cc = c2 - row * 9; o = (unsigned)(row * 64 * 2 + (cc < 7 ? cc : 7) * 16); }
        else o = (unsigned)(lane * 16);
        off[i] = o; }
}
__device__ __forceinline__ void gla_stage(LAS unsigned char* B, const bf16* QE, const bf16* KDT, const bf16* ATT, const float* DEC, int bseq, int h, int bh, int n, int hw, const unsigned (&off)[20]) {
    const int rbn = bseq * 32 + n, r0n = rbn * 64, ts = n * 64;
    const char* bq = (const char*)(QE + (size_t)r0n * DQK + h * DK); const char* bk = (const char*)(KDT + (size_t)(bh * DK) * 2048 + ts);
    const char* ba = (const char*)(ATT + (size_t)(rbn * 4 + h) * 4096); const char* bd = (const char*)(DEC + (size_t)(rbn * 4 + h) * DK);
#pragma unroll
    for (int i = 0; i < 20; ++i) { const int p = hw + 4 * i;
        if (p < 79) { const char* base = p < 33 ? bq : p < 69 ? bk : p < 78 ? ba : bd;
            __builtin_amdgcn_global_load_lds((const unsigned*)(base + off[i]), (LAS unsigned*)(B + p * 1024), 16, 0, 0); } }
}
__device__ __forceinline__ void gla_prompt(Frame& F, int l) {
    unsigned char* ws = F.ws;
    const bf16* QE = (const bf16*)(ws + WS_QE); const bf16* KDT = (const bf16*)(ws + WS_KDT); const bf16* VT = (const bf16*)(ws + WS_VT); const bf16* ATT = (const bf16*)(ws + WS_ATT);
    const float* DEC = (const float*)(ws + WS_DEC); bf16* O = (bf16*)(ws + WS_O); float* SSQ = (float*)(ws + WS_YB);
    typedef unsigned u32x2 __attribute__((ext_vector_type(2)));
    const int lane = F.lane, wave = F.wave, r = lane & 31, hh = lane >> 5;
    const int j = ((int)blockIdx.x & 7) * 8 + ((int)blockIdx.x >> 3), bseq = j >> 4, h = (j >> 2) & 3, bh = bseq * 4 + h, ec = (j & 3) * 128 + 32 * (wave & 3);
    const int NCH = 32 * (PROBE_DUP == 4 ? 2 : 1);
    if (wave >= 4) {
        unsigned soff[20]; gla_stage_offsets(wave - 4, lane, soff);
        gla_stage(F.lds, QE, KDT, ATT, DEC, bseq, h, bh, 0, wave - 4, soff);
        asm volatile("s_waitcnt vmcnt(0)" ::: "memory"); __builtin_amdgcn_s_barrier();
#pragma unroll 1
        for (int n_ = 0; n_ < NCH; ++n_) {
            if (n_ + 1 < NCH) gla_stage(F.lds + ((n_ + 1) & 1) * GBUF, QE, KDT, ATT, DEC, bseq, h, bh, (n_ + 1) & 31, wave - 4, soff);
            asm volatile("s_waitcnt vmcnt(0)" ::: "memory"); __builtin_amdgcn_s_barrier();
        }
    } else {
        f32x16 St[8];
#pragma unroll
        for (int i = 0; i < 8; ++i)
#pragma unroll
            for (int q = 0; q < 16; ++q) St[i][q] = 0.f;
        bf16x8 vA[4];
#pragma unroll
        for (int kk = 0; kk < 4; ++kk) vA[kk] = *(const GAS bf16x8*)(VT + ((size_t)(bh * DV + ec + r)) * 2048 + 16 * kk + 8 * hh);
        __builtin_amdgcn_s_barrier(); asm volatile("" ::: "memory");
#pragma unroll 1
        for (int n_ = 0; n_ < NCH; ++n_) { const int n = n_ & 31, b = n_ & 1;
            if (PROBE_DUP == 4 && n_ == 32) {
#pragma unroll
                for (int i = 0; i < 8; ++i)
#pragma unroll
                    for (int q = 0; q < 16; ++q) St[i][q] = 0.f; }
            const LAS unsigned char* Bq = F.lds + b * GBUF; const LAS unsigned char* Bk = Bq + 64 * GQ_STR; const LAS unsigned char* Ba = Bk + 256 * GK_STR; const LAS unsigned char* Bd = Ba + 64 * GA_STR;
            const int r0 = (bseq * 32 + n) * 64;
            f32x16 OT[2];
#pragma unroll
            for (int tt = 0; tt < 2; ++tt)
#pragma unroll
                for (int q = 0; q < 16; ++q) OT[tt][q] = 0.f;
#pragma unroll
            for (int dt = 0; dt < 8; ++dt)
#pragma unroll
                for (int sx = 0; sx < 2; ++sx) {
                    const v4u ap = {pg8::cvt_pk_bf16(St[dt][8 * sx + 0], St[dt][8 * sx + 1]), pg8::cvt_pk_bf16(St[dt][8 * sx + 2], St[dt][8 * sx + 3]), pg8::cvt_pk_bf16(St[dt][8 * sx + 4], St[dt][8 * sx + 5]), pg8::cvt_pk_bf16(St[dt][8 * sx + 6], St[dt][8 * sx + 7])};
                    const bf16x8 Af = __builtin_bit_cast(bf16x8, ap);
#pragma unroll
                    for (int tt = 0; tt < 2; ++tt) { const LAS unsigned char* p = Bq + (32 * tt + r) * GQ_STR + (32 * dt + 16 * sx + 4 * hh) * 2;
                        const u32x2 lo = *(const LAS u32x2*)p, hi = *(const LAS u32x2*)(p + 16); const v4u bv = {lo.x, lo.y, hi.x, hi.y};
                        OT[tt] = __builtin_amdgcn_mfma_f32_32x32x16_bf16(Af, __builtin_bit_cast(bf16x8, bv), OT[tt], 0, 0, 0); } }
#pragma unroll
            for (int kk = 0; kk < 4; ++kk)
#pragma unroll
                for (int tt = 0; tt < 2; ++tt) { const bf16x8 Bf = *(const LAS bf16x8*)(Ba + (32 * tt + r) * GA_STR + (16 * kk + 8 * hh) * 2);
                    OT[tt] = __builtin_amdgcn_mfma_f32_32x32x16_bf16(vA[kk], Bf, OT[tt], 0, 0, 0); }
#pragma unroll
            for (int tt = 0; tt < 2; ++tt)
#pragma unroll
                for (int q = 0; q < 4; ++q) *(GAS unsigned long long*)(O + (size_t)(r0 + 32 * tt + r) * D + h * DV + ec + 8 * q + 4 * hh) =
                    (unsigned long long)pg8::cvt_pk_bf16(OT[tt][4 * q], OT[tt][4 * q + 1]) | ((unsigned long long)pg8::cvt_pk_bf16(OT[tt][4 * q + 2], OT[tt][4 * q + 3]) << 32);
#pragma unroll
            for (int tt = 0; tt < 2; ++tt) { float sq = 0.f;
#pragma unroll
                for (int q = 0; q < 16; ++q) sq += OT[tt][q] * OT[tt][q];
                sq += __shfl_xor(sq, 32);
                if (hh == 0) SSQ[((size_t)(r0 + 32 * tt + r) * 4 + h) * 16 + (j & 3) * 4 + wave] = sq; }
#pragma unroll
            for (int dt = 0; dt < 8; ++dt) {
                { const f32x4 d0 = *(const LAS f32x4*)(Bd + (32 * dt + 4 * hh) * 4), d1 = *(const LAS f32x4*)(Bd + (32 * dt + 8 + 4 * hh) * 4), d2 = *(const LAS f32x4*)(Bd + (32 * dt + 16 + 4 * hh) * 4), d3 = *(const LAS f32x4*)(Bd + (32 * dt + 24 + 4 * hh) * 4);
                  const f32x16 dv = {d0.x, d0.y, d0.z, d0.w, d1.x, d1.y, d1.z, d1.w, d2.x, d2.y, d2.z, d2.w, d3.x, d3.y, d3.z, d3.w}; St[dt] = St[dt] * dv; }
#pragma unroll
                for (int kk = 0; kk < 4; ++kk) { const bf16x8 Af = *(const LAS bf16x8*)(Bk + (32 * dt + r) * GK_STR + (16 * kk + 8 * hh) * 2);
                    St[dt] = __builtin_amdgcn_mfma_f32_32x32x16_bf16(Af, vA[kk], St[dt], 0, 0, 0); } }
            if (n_ + 1 < NCH) {
#pragma unroll
                for (int kk = 0; kk < 4; ++kk) vA[kk] = *(const GAS bf16x8*)(VT + ((size_t)(bh * DV + ec + r)) * 2048 + ((n_ + 1) & 31) * 64 + 16 * kk + 8 * hh); }
            asm volatile("s_waitcnt lgkmcnt(0)" ::: "memory"); __builtin_amdgcn_s_barrier(); asm volatile("" ::: "memory");
        }
        float* og = F.out + OUT_GLAP + ((size_t)(l * 4 + bseq) * 4 + h) * (size_t)(DK * DV);
#pragma unroll
        for (int dt = 0; dt < 8; ++dt)
#pragma unroll
            for (int q = 0; q < 16; ++q) og[(size_t)(32 * dt + (q & 3) + 8 * (q >> 2) + 4 * hh) * DV + ec + r] = St[dt][q];
    }
    __syncthreads();
}
__device__ __forceinline__ int cu_grab(Frame& F, int first, unsigned* ctr) {
    __syncthreads();
    if (F.tid == 0) F.MISC[16] = (unsigned)first + __hip_atomic_fetch_add(ctr, 1u, __ATOMIC_RELAXED, __HIP_MEMORY_SCOPE_AGENT);
    __syncthreads();
    return (int)__builtin_amdgcn_readfirstlane(F.MISC[16]);
}
__device__ __forceinline__ void gla_sample(Frame& F, int l, int wgi, int NW, unsigned* qctr) {
    unsigned char* ws = F.ws;
    const bf16* P = (const bf16*)(ws + WS_P);
    const float* QES = (const float*)(ws + WS_QES); const float* KDS = (const float*)(ws + WS_KDS); const float* DECS = (const float*)(ws + WS_DECS); const float* ATTS = (const float*)(ws + WS_ATTS);
    bf16* O = (bf16*)(ws + WS_O);
    const int lane = F.lane, c = lane & 15, g = lane >> 4;
    int grp = wgi >= 0 ? wgi : cu_grab(F, NW, qctr);
#pragma unroll 1
    for (; grp < NSQ * NH; grp = cu_grab(F, NW, qctr)) { const int it = grp * 8 + F.wave;
        const int es = it & 7, h = (it >> 3) & 3, s = it >> 5, rowb = s * 8, prow = MP + rowb;
        f32x4 vB[2];
#pragma unroll
        for (int kk = 0; kk < 2; ++kk) { typedef unsigned u32x2 __attribute__((ext_vector_type(2)));
            const u32x2 w = *(const GAS u32x2*)(P + P_V(prow + 4 * kk + g, h) + es * 64 + 4 * c); vB[kk] = (f32x4){bflo(w.x), bfhi(w.x), bflo(w.y), bfhi(w.y)}; }
        const size_t sbase = (((size_t)(l * NSQ + s) * NH + h) * DK) * DV + es * 64 + 4 * c;
        const float* S0 = F.stG + sbase + (size_t)(4 * g) * DV; float* SO = F.out + OUT_GLAS + sbase + (size_t)(4 * g) * DV;
        const float* qrow = QES + (size_t)(rowb + (c & 7)) * DQK + h * DK + 4 * g;
        const float* drow = DECS + (size_t)s * DQK + h * DK + 4 * g;
        const float* k0row = KDS + (size_t)(rowb + g) * DQK + h * DK + c; const float* k1row = KDS + (size_t)(rowb + 4 + g) * DQK + h * DK + c;
        f32x4 oacc[4];
#pragma unroll
        for (int jj = 0; jj < 4; ++jj) oacc[jj] = (f32x4){0.f, 0.f, 0.f, 0.f};
        f32x4 St[4][4], qa[4], d4[4]; float k0[4], k1[4];
#define GS_LOAD(sl, blk) do { const int dkl = 16 * (blk); \
        _Pragma("unroll") for (int i = 0; i < 4; ++i) St[sl][i] = *(const GAS f32x4*)(S0 + (size_t)(dkl + i) * DV); \
        qa[sl] = *(const GAS f32x4*)(qrow + dkl); d4[sl] = *(const GAS f32x4*)(drow + dkl); k0[sl] = k0row[dkl]; k1[sl] = k1row[dkl]; } while (0)
        GS_LOAD(0, 0); GS_LOAD(1, 1); GS_LOAD(2, 2);
#pragma unroll 1
        for (int b4 = 0; b4 < 16; b4 += 4) {
#pragma unroll
            for (int u = 0; u < 4; ++u) { const int blk = b4 + u, dk0 = 16 * blk;
                if (blk + 3 < 16) GS_LOAD((u + 3) & 3, blk + 3);
                f32x4 Cj[4];
#pragma unroll
                for (int jj = 0; jj < 4; ++jj) {
#pragma unroll
                    for (int i = 0; i < 4; ++i) oacc[jj] = __builtin_amdgcn_mfma_f32_16x16x4f32(qa[u][i], St[u][i][jj], oacc[jj], 0, 0, 0);
                    f32x4 C = {St[u][0][jj] * d4[u][0], St[u][1][jj] * d4[u][1], St[u][2][jj] * d4[u][2], St[u][3][jj] * d4[u][3]};
                    C = __builtin_amdgcn_mfma_f32_16x16x4f32(k0[u], vB[0][jj], C, 0, 0, 0); C = __builtin_amdgcn_mfma_f32_16x16x4f32(k1[u], vB[1][jj], C, 0, 0, 0); Cj[jj] = C; }
#pragma unroll
                for (int i = 0; i < 4; ++i) *(GAS f32x4*)(SO + (size_t)(dk0 + i) * DV) = (f32x4){Cj[0][i], Cj[1][i], Cj[2][i], Cj[3][i]};
            }
        }
#undef GS_LOAD
        const float* arow = ATTS + (((size_t)s * 4 + h) * 8 + (c & 7)) * 8 + g;
        const float aA0 = arow[0], aA1 = arow[4];
#pragma unroll
        for (int jj = 0; jj < 4; ++jj) { oacc[jj] = __builtin_amdgcn_mfma_f32_16x16x4f32(aA0, vB[0][jj], oacc[jj], 0, 0, 0); oacc[jj] = __builtin_amdgcn_mfma_f32_16x16x4f32(aA1, vB[1][jj], oacc[jj], 0, 0, 0); }
        if (g < 2) {
#pragma unroll
            for (int i = 0; i < 4; ++i) *(GAS unsigned long long*)(O + (size_t)(prow + 4 * g + i) * D + h * DV + es * 64 + 4 * c) =
                (unsigned long long)pk2(oacc[0][i], oacc[1][i]) | ((unsigned long long)pk2(oacc[2][i], oacc[3][i]) << 32);
        }
        { float* SSQ = (float*)(ws + WS_YB);
#pragma unroll
            for (int i = 0; i < 4; ++i) { float sq = (oacc[0][i] * oacc[0][i] + oacc[1][i] * oacc[1][i]) + (oacc[2][i] * oacc[2][i] + oacc[3][i] * oacc[3][i]);
                sq += __shfl_xor(sq, 1); sq += __shfl_xor(sq, 2); sq += __shfl_xor(sq, 4); sq += __shfl_xor(sq, 8);
                if (c == 0 && g < 2) { float* sp = SSQ + ((size_t)(prow + 4 * g + i) * 4 + h) * 16; sp[es] = sq; sp[8 + es] = 0.f; } } }
    }
}
struct MergeRow { v4u ov[4], og[4], ga[4], gb[4], yb[4]; };
__device__ __forceinline__ void merge_load(MergeRow& R, const bf16* O, const bf16* P, const bf16* YB, int r, int lane) {
#pragma unroll
    for (int h = 0; h < 4; ++h) { const int col = 512 * h + 8 * lane;
        R.ov[h] = *(const GAS v4u*)(O + (size_t)r * D + col); R.og[h] = *(const GAS v4u*)(P + P_OG(r, h) + 8 * lane); R.ga[h] = *(const GAS v4u*)(P + P_GA(r, h) + 8 * lane);
        R.gb[h] = *(const GAS v4u*)(P + P_GB(r, h) + 8 * lane); R.yb[h] = *(const GAS v4u*)(YB + (size_t)r * D + col); }
}
__device__ __forceinline__ void merge_compute(const MergeRow& R, Frame& F, bf16* MG, int l, int r, int lane) {
#pragma unroll
    for (int h = 0; h < 4; ++h) { const int col = 512 * h + 8 * lane;
        const v4u ov = R.ov[h], ogv = R.og[h], gav = R.ga[h], gbv = R.gb[h], ybv = R.yb[h];
        float o[8], res[8]; float ss = 0.f;
#pragma unroll
        for (int q = 0; q < 4; ++q) { o[2 * q] = bflo(ov[q]); o[2 * q + 1] = bfhi(ov[q]); ss += o[2 * q] * o[2 * q] + o[2 * q + 1] * o[2 * q + 1]; }
        const float rstd = 1.0f / sqrtf(wave_sum(ss) * (1.0f / DV) + EPS);
#pragma unroll
        for (int q = 0; q < 8; ++q) { const unsigned ow = ogv[q >> 1], aw = gav[q >> 1], bw = gbv[q >> 1], yw = ybv[q >> 1];
            const float og = (q & 1) ? bfhi(ow) : bflo(ow), ga = (q & 1) ? bfhi(aw) : bflo(aw), gb = (q & 1) ? bfhi(bw) : bflo(bw), yb = (q & 1) ? bfhi(yw) : bflo(yw);
            const float ya = o[q] * rstd * F.gla_norm_g[(size_t)l * DV + 8 * lane + q] * (og * sigmoidf_(og));
            res[q] = sigmoidf_(ga) * ya + sigmoidf_(gb) * (yb * F.pool_scale[(size_t)l * D + col + q]); }
        *(GAS v4u*)(MG + (size_t)r * D + col) = (v4u){pk2(res[0], res[1]), pk2(res[2], res[3]), pk2(res[4], res[5]), pk2(res[6], res[7])};
    }
}
__device__ __forceinline__ void merge_rows(Frame& F, int l) {
    unsigned char* ws = F.ws;
    const bf16* P = (const bf16*)(ws + WS_P); const bf16* O = (const bf16*)(ws + WS_O); const bf16* YB = (const bf16*)(ws + WS_YB); bf16* MG = (bf16*)(ws + WS_MG);
    const int gw = F.vcu * NWAVES + F.wave, NGW = F.G * NWAVES, lane = F.lane;
    MergeRow A, B;
    if (gw < M) merge_load(A, O, P, YB, gw, lane);
#pragma unroll 1
    for (int r = gw; r < M; r += 2 * NGW) {
        const int r1 = r + NGW, r2 = r + 2 * NGW;
        if (r1 < M) merge_load(B, O, P, YB, r1, lane);
        merge_compute(A, F, MG, l, r, lane);
        if (r2 < M) merge_load(A, O, P, YB, r2, lane);
        if (r1 < M) merge_compute(B, F, MG, l, r1, lane);
    }
}

__device__ __forceinline__ float sgm_(float x) { return __builtin_amdgcn_rcpf(1.0f + __builtin_amdgcn_exp2f(-1.44269504089f * x)); }
__device__ __forceinline__ void poolmerge_phase(Frame& F, int l, int rb0) {
    unsigned char* ws = F.ws;
    const bf16* P = (const bf16*)(ws + WS_P); const bf16* O = (const bf16*)(ws + WS_O); const bf16* DM = (const bf16*)(ws + WS_DM); const bf16* WPL = (const bf16*)(ws + WS_WPL + (size_t)l * 1 * MiB);
    const float* SSQ = (const float*)(ws + WS_YB); bf16* MG = (bf16*)(ws + WS_MG);
    const float* gng = F.gla_norm_g + (size_t)l * DV; const float* psc = F.pool_scale + (size_t)l * D;
    const int gw = F.vcu * NWAVES + F.wave, NGW = F.G * NWAVES, lane = F.lane, c = lane & 15, g4 = lane >> 4;
#pragma unroll 1
    for (int it = rb0 * 16 + gw; it < (M / 16) * 16; it += NGW) {
        const int cq = it & 3, h = (it >> 2) & 3, row = (it >> 4) * 16 + c, cb = 128 * cq + 32 * g4;
        bf16x8 dB[8];
#pragma unroll
        for (int kk = 0; kk < 8; ++kk) dB[kk] = *(const GAS bf16x8*)(DM + (size_t)row * DPOOL + 256 * h + 32 * kk + 8 * g4);
        const bf16* wrow = WPL + (size_t)(512 * h + 128 * cq + 32 * (c >> 2) + (c & 3)) * 256 + 8 * g4;
        f32x4 acc[8];
#pragma unroll
        for (int nt = 0; nt < 8; ++nt) { acc[nt] = (f32x4){0.f, 0.f, 0.f, 0.f};
#pragma unroll
            for (int kk = 0; kk < 8; ++kk) { const bf16x8 Af = *(const GAS bf16x8*)(wrow + (size_t)(4 * nt) * 256 + 32 * kk);
                acc[nt] = __builtin_amdgcn_mfma_f32_16x16x32_bf16(Af, dB[kk], acc[nt], 0, 0, 0); } }
        const GAS f32x4* sp = (const GAS f32x4*)(SSQ + ((size_t)row * 4 + h) * 16); const f32x4 s0 = sp[0], s1 = sp[1], s2 = sp[2], s3 = sp[3];
        const float ss = ((s0[0] + s0[1]) + (s0[2] + s0[3])) + ((s1[0] + s1[1]) + (s1[2] + s1[3])) + ((s2[0] + s2[1]) + (s2[2] + s2[3])) + ((s3[0] + s3[1]) + (s3[2] + s3[3]));
        const float rstd = __builtin_amdgcn_rsqf(ss * (1.0f / DV) + EPS);
        v4u ov[4], ogv[4], gav[4], gbv[4];
#pragma unroll
        for (int q = 0; q < 4; ++q) { ov[q] = *(const GAS v4u*)(O + (size_t)row * D + 512 * h + cb + 8 * q); ogv[q] = *(const GAS v4u*)(P + P_OG(row, h) + cb + 8 * q);
            gav[q] = *(const GAS v4u*)(P + P_GA(row, h) + cb + 8 * q); gbv[q] = *(const GAS v4u*)(P + P_GB(row, h) + cb + 8 * q); }
#pragma unroll
        for (int q = 0; q < 4; ++q) { float res[8];
            const f32x4 gn0 = *(const GAS f32x4*)(gng + cb + 8 * q), gn1 = *(const GAS f32x4*)(gng + cb + 8 * q + 4), ps0 = *(const GAS f32x4*)(psc + 512 * h + cb + 8 * q), ps1 = *(const GAS f32x4*)(psc + 512 * h + cb + 8 * q + 4);
#pragma unroll
            for (int e = 0; e < 8; ++e) { const unsigned ow = ov[q][e >> 1], gw_ = ogv[q][e >> 1], aw = gav[q][e >> 1], bw = gbv[q][e >> 1];
                const float o = (e & 1) ? bfhi(ow) : bflo(ow), og = (e & 1) ? bfhi(gw_) : bflo(gw_), ga = (e & 1) ? bfhi(aw) : bflo(aw), gb = (e & 1) ? bfhi(bw) : bflo(bw);
                const float gn = e < 4 ? gn0[e & 3] : gn1[e & 3], ps = e < 4 ? ps0[e & 3] : ps1[e & 3], yb = acc[2 * q + (e >> 2)][e & 3] * ps;
                res[e] = sgm_(ga) * (o * rstd * gn * (og * sgm_(og))) + sgm_(gb) * yb; }
            *(GAS v4u*)(MG + (size_t)row * D + 512 * h + cb + 8 * q) = (v4u){pk2(res[0], res[1]), pk2(res[2], res[3]), pk2(res[4], res[5]), pk2(res[6], res[7])}; }
    }
}

__device__ __forceinline__ bool probe_group(int k) {
    const int j = (k >= 2 && k < 22) ? (k - 2) % 10 : -1;
    const bool gemm = (j == 1 || j == 4 || j == 6 || j == 8 || j == 9), mix = (j == 2 || j == 3);
    if (PROBE_DUP >= 30 && PROBE_DUP < 40) return j == PROBE_DUP - 30;
    if (PROBE_DUP >= 50) return false;
    if (PROBE_DUP >= 40) return k == (PROBE_DUP == 40 ? 0 : PROBE_DUP == 41 ? 1 : 22);
    return PROBE_DUP == 21 ? gemm : PROBE_DUP == 22 ? mix : PROBE_DUP == 23 ? !(gemm || mix) : false;
}
#define IN(k) (lo <= (k) && (k) < hi)
#define SEAM(k) do { if (IN(k) && IN((k) + 1)) { xcd_barrier(bar); if (PROBE_DUP == 7) xcd_barrier(bar); } if (PROBE_DUP >= 21) { const unsigned long long now_ = __builtin_amdgcn_s_memrealtime(); if (probe_group(k)) tsum += now_ - tlast; tlast = now_; } } while (0)
template <int l>
__device__ __forceinline__ void layer_phases(Frame& F, const XcdBarrier& bar, const int lo, const int hi, unsigned long long& tsum, unsigned long long& tlast) {
    unsigned char* ws = F.ws;
    float* MOD = (float*)(ws + WS_MOD); bf16* XN = (bf16*)(ws + WS_XN); bf16* Pm = (bf16*)(ws + WS_P);
    float* X1 = (float*)(ws + WS_X1); float* X2 = (float*)(ws + WS_X2); bf16* SLAB = (bf16*)(ws + WS_SLAB);
        const int pb = 2 + 10 * l;
        const float* xinP = l == 0 ? F.xP : X2; const float* xinS = l == 0 ? F.xS : X2 + (size_t)MP * D;
        const float* modl = MOD + (size_t)l * NADA;
        if (IN(pb + 0)) for (int rep_ = 0; rep_ < (PROBE_DUP == 8 ? 2 : 1); ++rep_) { if (l == 0) norm_rows(F, xinP, xinS, F.norm1_g + (size_t)l * D, modl, XN, nullptr, nullptr, nullptr, nullptr);
                          else norm_rows(F, xinP, xinS, F.norm1_g + (size_t)l * D, modl, XN, SLAB, X1 + (size_t)MP * D, MOD + (size_t)(l - 1) * NADA + 5 * D, X2); }
        SEAM(pb + 0);
        if (IN(pb + 1)) {
            pg8::Gemm g{XN, (const bf16*)(ws + WS_WIN + (size_t)l * 45 * MiB), M, NINP, D, D, D, 1, 0}; pg8::StaticOrder S; S.init(M, NINP, F.G, (int)blockIdx.x, D);
            pg8::EpiWin E{Pm, M};
            for (int rep_ = 0; rep_ < (PROBE_DUP == 6 ? 2 : 1); ++rep_) pg8::gemm_phase<pg8::EpiWin, pg8::StaticOrder, true, true>(F.lds, g, S, E);
            if (l == 0) conv_in_tail<CV_PL | CV_O | CV_GU | CV_DN>(F, 0, S.nwg); else conv_in_tail<CV_GU>(F, 1, S.nwg);
        }
        SEAM(pb + 1);
#ifndef NO_PREP
        if (IN(pb + 2)) { for (int rep_ = 0; rep_ < (PROBE_DUP == 2 ? 2 : 1); ++rep_) {
            unsigned long long tq0_ = 0ull; if (PROBE_DUP == 52 || PROBE_DUP == 53) tq0_ = __builtin_amdgcn_s_memrealtime();
            prep_phase(F, l);
            if (PROBE_DUP == 52 || PROBE_DUP == 53) { xcd_barrier(bar); const unsigned long long t1_ = __builtin_amdgcn_s_memrealtime(); if (PROBE_DUP == 52) tsum += t1_ - tq0_; tq0_ = t1_; }
            pool_rows(F, l);
            if (PROBE_DUP == 52 || PROBE_DUP == 53) { xcd_barrier(bar); const unsigned long long t1_ = __builtin_amdgcn_s_memrealtime(); if (PROBE_DUP == 53) tsum += t1_ - tq0_; } } }
#endif
        SEAM(pb + 2);
        if (IN(pb + 3)) {
            if (F.G >= 128) {
                unsigned long long tq0_ = 0ull;
                if (PROBE_DUP == 50 || PROBE_DUP == 51) tq0_ = __builtin_amdgcn_s_memrealtime();
                unsigned* qctr = (unsigned*)(F.ctl + CW_GLAQ + 64 * l);
                if ((int)blockIdx.x < 64) { gla_prompt(F, l); gla_sample(F, l, -1, F.G - 64, qctr); }
                if (PROBE_DUP == 50 || PROBE_DUP == 51) { xcd_barrier(bar); const unsigned long long t1_ = __builtin_amdgcn_s_memrealtime(); if (PROBE_DUP == 50) tsum += t1_ - tq0_; tq0_ = t1_; }
                if ((int)blockIdx.x >= 64) gla_sample(F, l, (int)blockIdx.x - 64, F.G - 64, qctr);
                if (PROBE_DUP == 50 || PROBE_DUP == 51) { xcd_barrier(bar); const unsigned long long t1_ = __builtin_amdgcn_s_memrealtime(); if (PROBE_DUP == 51) tsum += t1_ - tq0_; }
            }
        }
        SEAM(pb + 3);
        if (IN(pb + 4)) {
            pg8::Gemm g{(const bf16*)(ws + WS_DM), (const bf16*)(ws + WS_WPL + (size_t)l * 1 * MiB), MP, D, 256, DPOOL, 256, 2, 512}; pg8::StaticOrder S; S.init(MP, D, F.G, (int)blockIdx.x, 256);
            pg8::EpiMerge E{(bf16*)(ws + WS_MG), (const bf16*)(ws + WS_O), Pm, (const float*)(ws + WS_YB), F.gla_norm_g + (size_t)l * DV, F.pool_scale + (size_t)l * D, M};
            for (int rep_ = 0; rep_ < (PROBE_DUP == 10 ? 2 : 1); ++rep_) pg8::gemm_phase<pg8::EpiMerge, pg8::StaticOrder, true, true>(F.lds, g, S, E);
            poolmerge_phase(F, l, MP / 16);
        }
        SEAM(pb + 4);
#ifndef NO_MERGE
#endif
        if (IN(pb + 6)) {
            pg8::Gemm g{(const bf16*)(ws + WS_MG), (const bf16*)(ws + WS_WO + (size_t)l * 8 * MiB), M, D, D, D, D, 1, 0}; pg8::SplitOrder S; S.init(F.G, (int)blockIdx.x, D);
            pg8::EpiResGate E{xinP, xinS, X1, D, modl + 2 * D, NMOD, SLAB};
            for (int rep_ = 0; rep_ < (PROBE_DUP == 10 ? 2 : 1); ++rep_) pg8::gemm_phase<pg8::EpiResGate, pg8::SplitOrder, true, true>(F.lds, g, S, E);
        }
        SEAM(pb + 6);
        if (IN(pb + 7)) for (int rep_ = 0; rep_ < (PROBE_DUP == 8 ? 2 : 1); ++rep_) norm_rows(F, X1, X1 + (size_t)MP * D, F.norm2_g + (size_t)l * D, modl + 3 * D, XN, SLAB, xinS, modl + 2 * D, X1);
        SEAM(pb + 7);
        if (IN(pb + 8)) {
            pg8::Gemm g{XN, (const bf16*)(ws + WS_WGU + (size_t)l * 44 * MiB), M, NGU, D, D, D, 1, 0}; pg8::StaticOrder S; S.init(M, NGU, F.G, (int)blockIdx.x, D);
            pg8::EpiSwiGLU E{(bf16*)(ws + WS_ACT), DFF};
            for (int rep_ = 0; rep_ < (PROBE_DUP == 9 ? 2 : 1); ++rep_) pg8::gemm_phase<pg8::EpiSwiGLU, pg8::StaticOrder, true, true>(F.lds, g, S, E);
            if (l == 0) conv_in_tail<CV_IN | CV_PL | CV_O | CV_DN>(F, 1, S.nwg);
        }
        SEAM(pb + 8);
        if (IN(pb + 9)) {
            pg8::Gemm g{(const bf16*)(ws + WS_ACT), (const bf16*)(ws + WS_WDN + (size_t)l * 22 * MiB), M, D, DFF, DFF, DFF, 1, 0}; pg8::SplitOrder S; S.init(F.G, (int)blockIdx.x, DFF);
            pg8::EpiResGate E{X1, X1 + (size_t)MP * D, X2, D, modl + 5 * D, NMOD, SLAB};
            for (int rep_ = 0; rep_ < (PROBE_DUP == 5 ? 2 : 1); ++rep_) pg8::gemm_phase<pg8::EpiResGate, pg8::SplitOrder, true, true>(F.lds, g, S, E);
        }
        SEAM(pb + 9);
    }
#undef IN
#undef SEAM

constexpr int NPHASE = 23;
struct Args { const float* in[20]; float* out; unsigned char* ws; int ph_lo, ph_hi; };
__global__ void __launch_bounds__(NWAVES * 64, 2) fwd(Args args) {
    extern __shared__ __attribute__((aligned(16))) unsigned char lds[];
    Frame F;
    F.lds = (LAS unsigned char*)lds; F.MISC = (volatile LAS unsigned*)(F.lds + MISC_OFF);
    F.tid = threadIdx.x; F.lane = F.tid & 63; F.wave = __builtin_amdgcn_readfirstlane(F.tid >> 6);
    F.G = gridDim.x; { const int bx = blockIdx.x; F.vcu = (F.G % 8 == 0) ? (bx % 8) * (F.G / 8) + bx / 8 : bx; }
    F.xP = args.in[0]; F.xS = args.in[1]; F.stG = args.in[2]; F.stP = args.in[3]; F.cP = args.in[4]; F.cS = args.in[5]; F.w_ada = args.in[6]; F.b_ada = args.in[7]; F.norm1_g = args.in[8];
    F.w_in = args.in[9]; F.w_a2 = args.in[10]; F.b_a = args.in[11]; F.gla_norm_g = args.in[12]; F.w_pool = args.in[13]; F.pool_scale = args.in[14]; F.w_o = args.in[15]; F.norm2_g = args.in[16];
    F.w_gu = args.in[17]; F.w_down = args.in[18]; F.final_g = args.in[19]; F.out = args.out; F.ws = args.ws;
    unsigned char* ws = args.ws;
    F.ctl = (gu32*)(ws + WS_CTL);
    if (F.tid < 64) F.MISC[F.tid] = 0u;
    __syncthreads();
    const int lo = args.ph_lo, hi = args.ph_hi;
    XcdBarrier bar; bar.bar = (unsigned*)(F.ctl + CW_BAR); bar.x = 0; bar.st = nullptr;
    if (hi - lo > 1) bar = xcd_barrier_post((unsigned*)(F.ctl + CW_BAR), F.MISC + 8);
    unsigned long long tsum = 0ull, tlast = (PROBE_DUP >= 21) ? __builtin_amdgcn_s_memrealtime() : 0ull;
#define IN(k) (lo <= (k) && (k) < hi)
#define SEAM(k) do { if (IN(k) && IN((k) + 1)) { xcd_barrier(bar); if (PROBE_DUP == 7) xcd_barrier(bar); } if (PROBE_DUP >= 21) { const unsigned long long now_ = __builtin_amdgcn_s_memrealtime(); if (probe_group(k)) tsum += now_ - tlast; tlast = now_; } } while (0)
    float* MOD = (float*)(ws + WS_MOD); bf16* XN = (bf16*)(ws + WS_XN); bf16* Pm = (bf16*)(ws + WS_P);
    float* X1 = (float*)(ws + WS_X1); float* X2 = (float*)(ws + WS_X2);

#ifndef NO_P0
    if (IN(0)) { for (int rep_ = 0; rep_ < (PROBE_DUP == 1 ? 2 : 1); ++rep_) { p0_convert(F); if (PROBE_DUP == 1) { __syncthreads(); } } }
#endif
    SEAM(0);
    if (IN(1)) { ada_direct(F); conv_set<CV_IN>(F, 0, F.vcu * NWAVES + F.wave, F.G * NWAVES); }
    SEAM(1);
    layer_phases<0>(F, bar, lo, hi, tsum, tlast);
    layer_phases<1>(F, bar, lo, hi, tsum, tlast);
    if (IN(22)) for (int rep_ = 0; rep_ < (PROBE_DUP == 8 ? 2 : 1); ++rep_) final_norm(F, X2, (const bf16*)(ws + WS_SLAB), X1 + (size_t)MP * D, MOD + (size_t)NADA + 5 * D);
    if (PROBE_DUP >= 21 && blockIdx.x == 0 && F.wave == 0) { const unsigned long long now_ = __builtin_amdgcn_s_memrealtime(); if (probe_group(22)) tsum += now_ - tlast;
        const unsigned long long tend = now_ + tsum; while (__builtin_amdgcn_s_memrealtime() < tend) __builtin_amdgcn_s_sleep(8); }
#undef IN
#undef SEAM
}

extern "C" void kernel_launch(void* const* d_in, const int* in_sizes, int n_in, void* d_out, int out_size, void* d_ws, size_t ws_size, hipStream_t stream) {
    static int grid = 0;
    if (grid == 0) {
        if (n_in != 20 || (size_t)out_size != OUT_END || ws_size < WS_END) { fprintf(stderr, "kernel_launch: unexpected shapes (n_in %d, out %d, ws %zu)\n", n_in, out_size, ws_size); grid = -1; return; }
        int dev = 0, cus = 0, per_cu = 0;
        if (hipGetDevice(&dev) != hipSuccess || hipDeviceGetAttribute(&cus, hipDeviceAttributeMultiprocessorCount, dev) != hipSuccess) { grid = -1; return; }
        if (hipFuncSetAttribute((const void*)fwd, hipFuncAttributeMaxDynamicSharedMemorySize, LDS_BYTES) != hipSuccess) { fprintf(stderr, "kernel_launch: hipFuncSetAttribute failed\n"); grid = -1; return; }
        if (hipOccupancyMaxActiveBlocksPerMultiprocessor(&per_cu, (const void*)fwd, NWAVES * 64, LDS_BYTES) != hipSuccess || per_cu < 1) fprintf(stderr, "kernel_launch: occupancy query says %d\n", per_cu);
        (void)hipGetLastError();
        grid = cus;
    }
    if (grid < 0) return;
    if (hipMemsetAsync((char*)d_ws + WS_CTL, 0, CTL_ZERO_BYTES, stream) != hipSuccess) return;
    Args a{};
    for (int i = 0; i < 20; ++i) a.in[i] = (const float*)d_in[i];
    a.out = (float*)d_out; a.ws = (unsigned char*)d_ws;
#if MK_N_LAUNCHES == 1
    a.ph_lo = 0; a.ph_hi = NPHASE;
    hipLaunchKernelGGL(fwd, dim3(grid), dim3(NWAVES * 64), LDS_BYTES, stream, a);
#else
    for (int p = 0; p < NPHASE; ++p) { a.ph_lo = p; a.ph_hi = p + 1; hipLaunchKernelGGL(fwd, dim3(grid), dim3(NWAVES * 64), LDS_BYTES, stream, a); }
#endif
}
```

```cpp
#include <hip/hip_runtime.h>
#include <cstdio>
#include <cstdint>
#ifndef MK_N_LAUNCHES
#define MK_N_LAUNCHES 1
#endif
#ifndef PROBE_DUP
#define PROBE_DUP 0
#endif
namespace pg8 {
#define PG8_LAS __attribute__((address_space(3)))
typedef unsigned short bf16_t;
typedef short bf16x8 __attribute__((ext_vector_type(8)));
typedef float f32x4 __attribute__((ext_vector_type(4)));
typedef unsigned u32x4 __attribute__((ext_vector_type(4)));
constexpr int BM = 256, BK = 64, HALF = 128, HTB = HALF * BK * 2  , STAGE_BYTES = 8 * HTB, NXCD = 8, WGM = 8;

__host__ __device__ __forceinline__ int lds_byte(int r, int c) { const int st = (r >> 4) * 2 + (c >> 5), rr = r & 15, cc = c & 31, ob = rr * 64 + cc * 2; return st * 1024 + (ob ^ (((ob >> 9) & 1) << 5)); }
__host__ __device__ __forceinline__ void stage_rc(int b, int& R, int& C) { const int st = b / 1024, sb = b % 1024, swz = sb ^ (((sb >> 9) & 1) << 5); R = (st >> 1) * 16 + swz / 64; C = (st & 1) * 32 + (swz % 64) / 2; }
__host__ __device__ __forceinline__ int perm32(int rho) { const int n = rho >> 4, i = rho & 15; return 8 * (i >> 2) + 4 * n + (i & 3); }

struct Unit { int pm, pn, kofs, nt, slice; };
struct Gemm { const bf16_t* A; const bf16_t* Bt; int M, N, K, lda, ldb, grp_div, grp_a_off; };

struct StaticOrder {
    int nM, nN, nwg, G, c, ntk;
    __host__ __device__ void init(int M, int N, int G_, int c_, int K) { nM = M / BM; nN = N / BM; nwg = nM * nN; G = G_; c = c_; ntk = K / BK; }
    __host__ __device__ void tile(int L, Unit& u) const {
        int wgid = L; { const int q = nwg / NXCD, r = nwg % NXCD, xcd = wgid % NXCD, off = wgid / NXCD; wgid = (xcd < r ? xcd * (q + 1) : r * (q + 1) + (xcd - r) * q) + off; }
        const int nig = WGM * nN, gid = wgid / nig, fm = gid * WGM, gsz = (nM - fm) < WGM ? (nM - fm) : WGM;
        u.pm = fm + ((wgid % nig) % gsz); u.pn = (wgid % nig) / gsz; u.kofs = 0; u.nt = ntk; u.slice = -1;
    }
    __host__ __device__ bool next(int i, Unit& u) const { const long L = (long)i * G + c; if (L >= nwg) return false; tile((int)L, u); return true; }
    __device__ __forceinline__ void a_ready(const Unit&) const {}
    __device__ __forceinline__ void done(const Unit&) const {}
};
struct SplitOrder {
    StaticOrder P; int G, c, ntk;
    __host__ __device__ void init(int G_, int c_, int K) { P.init(8192, 2048, G_, c_, K); G = G_; c = c_; ntk = K / BK; }
    __host__ __device__ bool next(int i, Unit& u) const {
        const long L = (long)i * G + c;
        if (L < 256) { P.tile((int)L, u); return true; }
        const int q = (int)L - 256; if (q >= 256) return false;
        const int t = q >> 3, s = q & 7, h = ntk >> 1, p0 = (s * h) >> 3, p1 = ((s + 1) * h) >> 3;
        u.pm = 32 + (t >> 3); u.pn = t & 7; u.kofs = 2 * p0 * BK; u.nt = 2 * (p1 - p0); u.slice = s; return true;
    }
    __device__ __forceinline__ void a_ready(const Unit&) const {}
    __device__ __forceinline__ void done(const Unit&) const {}
};

typedef __bf16 bf16x2_t __attribute__((ext_vector_type(2)));
typedef float f32x2_t __attribute__((ext_vector_type(2)));
__device__ __forceinline__ unsigned cvt_pk_bf16(float lo, float hi) { const f32x2_t v = {lo, hi}; const bf16x2_t r = __builtin_convertvector(v, bf16x2_t); return __builtin_bit_cast(unsigned, r); }
__device__ __forceinline__ int seq_of_row(int r) { return r < 8192 ? (r >> 11) : 4 + ((r - 8192) >> 3); }

struct EpiF32Bias {
    static constexpr bool PERM = false, AFTER_DRAIN = false;
    float* C; int ldc; const float* bias;
    __device__ __forceinline__ void operator()(const f32x4 (&acc)[2][2][4][2], const Unit& u, int wr, int wc, int fr, int fq) const {
        const int row0 = u.pm * BM + wr * 64 + fr, col0 = u.pn * BM + wc * 32 + 4 * fq;
        f32x4 bv[2][2];
#pragma unroll
        for (int bj = 0; bj < 2; ++bj)
#pragma unroll
            for (int n = 0; n < 2; ++n) bv[bj][n] = *(const f32x4*)(bias + col0 + bj * HALF + n * 16);
#pragma unroll
        for (int ai = 0; ai < 2; ++ai)
#pragma unroll
            for (int m = 0; m < 4; ++m) { float* rowp = C + (size_t)(row0 + ai * HALF + m * 16) * ldc + col0;
#pragma unroll
                for (int bj = 0; bj < 2; ++bj)
#pragma unroll
                    for (int n = 0; n < 2; ++n) *(f32x4*)(rowp + bj * HALF + n * 16) = acc[ai][bj][m][n] + bv[bj][n]; }
    }
};
struct EpiBf16Plain {
    static constexpr bool PERM = true, AFTER_DRAIN = false;
    bf16_t* O; int ldc;
    __device__ __forceinline__ void operator()(const f32x4 (&acc)[2][2][4][2], const Unit& u, int wr, int wc, int fr, int fq) const {
        const int row0 = u.pm * BM + wr * 64 + fr, col0 = u.pn * BM + wc * 32 + 8 * fq;
#pragma unroll
        for (int ai = 0; ai < 2; ++ai)
#pragma unroll
            for (int m = 0; m < 4; ++m) { bf16_t* rowp = O + (size_t)(row0 + ai * HALF + m * 16) * ldc + col0;
#pragma unroll
                for (int bj = 0; bj < 2; ++bj) { const f32x4 v0 = acc[ai][bj][m][0], v1 = acc[ai][bj][m][1];
                    u32x4 w; w.x = cvt_pk_bf16(v0[0], v0[1]); w.y = cvt_pk_bf16(v0[2], v0[3]); w.z = cvt_pk_bf16(v1[0], v1[1]); w.w = cvt_pk_bf16(v1[2], v1[3]);
                    *(u32x4*)(rowp + bj * HALF) = w; } }
    }
};
struct EpiWin {
    static constexpr bool PERM = true, AFTER_DRAIN = false;
    bf16_t* O; int Mrows;
    __device__ __forceinline__ void operator()(const f32x4 (&acc)[2][2][4][2], const Unit& u, int wr, int wc, int fr, int fq) const {
        const int row0 = u.pm * BM + wr * 64 + fr, pn = u.pn; const bool wide = (pn >= 8 && pn < 24) || (pn >= 28 && pn < 44);
        const int ldc = wide ? 512 : 256; bf16_t* base = O + (size_t)(wide ? (pn & ~1) : pn) * Mrows * 256 + (wide ? (pn & 1) * 256 : 0) + wc * 32 + 8 * fq;
#pragma unroll
        for (int ai = 0; ai < 2; ++ai)
#pragma unroll
            for (int m = 0; m < 4; ++m) { bf16_t* rowp = base + (size_t)(row0 + ai * HALF + m * 16) * ldc;
#pragma unroll
                for (int bj = 0; bj < 2; ++bj) { const f32x4 v0 = acc[ai][bj][m][0], v1 = acc[ai][bj][m][1];
                    u32x4 w; w.x = cvt_pk_bf16(v0[0], v0[1]); w.y = cvt_pk_bf16(v0[2], v0[3]); w.z = cvt_pk_bf16(v1[0], v1[1]); w.w = cvt_pk_bf16(v1[2], v1[3]);
                    *(u32x4*)(rowp + bj * HALF) = w; } }
    }
};
struct EpiMerge {
    static constexpr bool PERM = true, AFTER_DRAIN = false;
    bf16_t* MG; const bf16_t* O; const bf16_t* Pb; const float* ssq; const float* gng; const float* psc; int Mrows;
    __device__ __forceinline__ static float sg(float x) { return __builtin_amdgcn_rcpf(1.0f + __builtin_amdgcn_exp2f(-1.44269504089f * x)); }
    __device__ __forceinline__ static float lo(unsigned w) { return __builtin_bit_cast(float, w << 16); }
    __device__ __forceinline__ static float hi(unsigned w) { return __builtin_bit_cast(float, w & 0xffff0000u); }
    __device__ __forceinline__ void operator()(const f32x4 (&acc)[2][2][4][2], const Unit& u, int wr, int wc, int fr, int fq) const {
        const int row0 = u.pm * BM + wr * 64 + fr, h = u.pn >> 1, e0 = (u.pn & 1) * 256 + wc * 32 + 8 * fq;
        const size_t PLs = (size_t)Mrows * 256;
        const bf16_t* pog = Pb + (size_t)(16 + 2 * h) * PLs + e0; const bf16_t* pga = Pb + (size_t)(28 + 2 * h) * PLs + e0; const bf16_t* pgb = Pb + (size_t)(36 + 2 * h) * PLs + e0;
        f32x4 gn[2][2], ps[2][2];
#pragma unroll
        for (int bj = 0; bj < 2; ++bj)
#pragma unroll
            for (int n = 0; n < 2; ++n) { gn[bj][n] = *(const f32x4*)(gng + e0 + 128 * bj + 4 * n); ps[bj][n] = *(const f32x4*)(psc + 512 * h + e0 + 128 * bj + 4 * n); }
#pragma unroll
        for (int ai = 0; ai < 2; ++ai)
#pragma unroll
            for (int m = 0; m < 4; ++m) { const int row = row0 + ai * HALF + m * 16;
                const f32x4* sp = (const f32x4*)(ssq + ((size_t)row * 4 + h) * 16); const f32x4 s0 = sp[0], s1 = sp[1], s2 = sp[2], s3 = sp[3];
                const float ss = ((s0[0] + s0[1]) + (s0[2] + s0[3])) + ((s1[0] + s1[1]) + (s1[2] + s1[3])) + ((s2[0] + s2[1]) + (s2[2] + s2[3])) + ((s3[0] + s3[1]) + (s3[2] + s3[3]));
                const float rstd = __builtin_amdgcn_rsqf(ss * (1.0f / 512.0f) + 1e-6f);
#pragma unroll
                for (int bj = 0; bj < 2; ++bj) { const size_t ro = (size_t)row * 512 + 128 * bj;
                    const u32x4 ov = *(const u32x4*)(O + (size_t)row * 2048 + 512 * h + e0 + 128 * bj), ogv = *(const u32x4*)(pog + ro), gav = *(const u32x4*)(pga + ro), gbv = *(const u32x4*)(pgb + ro);
                    float res[8];
#pragma unroll
                    for (int q = 0; q < 8; ++q) { const unsigned ow = ov[q >> 1], gw_ = ogv[q >> 1], aw = gav[q >> 1], bw = gbv[q >> 1];
                        const float o = (q & 1) ? hi(ow) : lo(ow), og = (q & 1) ? hi(gw_) : lo(gw_), ga = (q & 1) ? hi(aw) : lo(aw), gb = (q & 1) ? hi(bw) : lo(bw);
                        const float ya = o * rstd * gn[bj][q >> 2][q & 3] * (og * sg(og)), yb = acc[ai][bj][m][q >> 2][q & 3] * ps[bj][q >> 2][q & 3];
                        res[q] = sg(ga) * ya + sg(gb) * yb; }
                    u32x4 w; w.x = cvt_pk_bf16(res[0], res[1]); w.y = cvt_pk_bf16(res[2], res[3]); w.z = cvt_pk_bf16(res[4], res[5]); w.w = cvt_pk_bf16(res[6], res[7]);
                    *(u32x4*)(MG + (size_t)row * 2048 + 512 * h + e0 + 128 * bj) = w; }
                if (m & 1) asm volatile("" ::: "memory"); }
    }
};
struct EpiResGate {
    static constexpr bool PERM = false, AFTER_DRAIN = false;
    const float* baseP; const float* baseS; float* out; int ldc; const float* gate; int gate_ld; bf16_t* slab;
    __device__ __forceinline__ void operator()(const f32x4 (&acc)[2][2][4][2], const Unit& u, int wr, int wc, int fr, int fq) const {
        const int row0 = u.pm * BM + wr * 64 + fr, col0 = u.pn * BM + wc * 32 + 4 * fq;
        if (u.slice >= 0) {
#pragma unroll
            for (int ai = 0; ai < 2; ++ai)
#pragma unroll
                for (int m = 0; m < 4; ++m) { bf16_t* op = slab + ((size_t)u.slice * 1024 + (row0 + ai * HALF + m * 16 - 8192)) * ldc + col0;
#pragma unroll
                    for (int bj = 0; bj < 2; ++bj)
#pragma unroll
                        for (int n = 0; n < 2; ++n) { const f32x4 v = acc[ai][bj][m][n]; typedef unsigned u32x2 __attribute__((ext_vector_type(2)));
                            *(u32x2*)(op + bj * HALF + n * 16) = (u32x2){cvt_pk_bf16(v[0], v[1]), cvt_pk_bf16(v[2], v[3])}; } }
            return;
        }
#pragma unroll
        for (int ai = 0; ai < 2; ++ai)
#pragma unroll
            for (int m = 0; m < 4; ++m) { const int row = row0 + ai * HALF + m * 16;
                const float* bp = (row < 8192 ? baseP + (size_t)row * ldc : baseS + (size_t)(row - 8192) * ldc) + col0;
                const float* gp = gate + (size_t)seq_of_row(row) * gate_ld + col0; float* op = out + (size_t)row * ldc + col0;
#pragma unroll
                for (int bj = 0; bj < 2; ++bj)
#pragma unroll
                    for (int n = 0; n < 2; ++n) { const f32x4 b = *(const f32x4*)(bp + bj * HALF + n * 16), gt = *(const f32x4*)(gp + bj * HALF + n * 16);
                        *(f32x4*)(op + bj * HALF + n * 16) = b + gt * acc[ai][bj][m][n]; }
                if (m & 1) asm volatile("" ::: "memory"); }
    }
};
struct EpiSwiGLU {
    static constexpr bool PERM = true, AFTER_DRAIN = false;
    bf16_t* O; int ldc;
    __device__ __forceinline__ static float act(float g, float up) { return g * __builtin_amdgcn_rcpf(1.0f + __builtin_amdgcn_exp2f(-1.44269504089f * g)) * up; }
    __device__ __forceinline__ void operator()(const f32x4 (&acc)[2][2][4][2], const Unit& u, int wr, int wc, int fr, int fq) const {
        const int row0 = u.pm * BM + wr * 64 + fr, col0 = u.pn * HALF + wc * 32 + 8 * fq;
#pragma unroll
        for (int ai = 0; ai < 2; ++ai)
#pragma unroll
            for (int m = 0; m < 4; ++m) { bf16_t* rowp = O + (size_t)(row0 + ai * HALF + m * 16) * ldc + col0;
                const f32x4 g0 = acc[ai][0][m][0], g1 = acc[ai][0][m][1], u0 = acc[ai][1][m][0], u1 = acc[ai][1][m][1];
                u32x4 w; w.x = cvt_pk_bf16(act(g0[0], u0[0]), act(g0[1], u0[1])); w.y = cvt_pk_bf16(act(g0[2], u0[2]), act(g0[3], u0[3]));
                w.z = cvt_pk_bf16(act(g1[0], u1[0]), act(g1[1], u1[1])); w.w = cvt_pk_bf16(act(g1[2], u1[2]), act(g1[3], u1[3]));
                *(u32x4*)rowp = w; }
    }
};

template <class Epi, class Sched, bool ALIGN_EPI = false, bool SP2 = false>
__device__ __forceinline__ void gemm_phase(PG8_LAS unsigned char* lds, const Gemm g, const Sched& S, const Epi& E) {
    const int tid = threadIdx.x, wid = __builtin_amdgcn_readfirstlane(tid >> 6), lane = tid & 63, wr = wid >> 2, wc = wid & 3, fr = lane & 15, fq = lane >> 4;
    unsigned voffA[2], voffB[2];
#pragma unroll
    for (int i = 0; i < 2; ++i) { int R, C; stage_rc(tid * 16 + i * 8192, R, C); const int Rb = Epi::PERM ? ((R & ~31) + perm32(R & 31)) : R;
        voffA[i] = (unsigned)(R * g.lda + C) * 2u; voffB[i] = (unsigned)(Rb * g.ldb + C) * 2u; }
    const size_t kstep = (size_t)(BK * 2);
    const size_t hstepA = (size_t)HALF * g.lda * 2, hstepB = (size_t)HALF * g.ldb * 2;
    const size_t tstepA = 2 * hstepA, tstepB = 2 * hstepB;
    const unsigned ldsw = (unsigned)wid * 1024u;
    const int aoff = lds_byte(wr * 64 + fr, fq * 8), boff = lds_byte(wc * 32 + fr, fq * 8);
#define PG8_SA(b, h) (((b) * 2 + (h)) * HTB)
#define PG8_SB(b, h) ((4 + (b) * 2 + (h)) * HTB)
#define PG8_STAGE(bufoff, gbase, voff) do { _Pragma("unroll") for (int _i = 0; _i < 2; ++_i) \
        __builtin_amdgcn_global_load_lds((const unsigned*)((const char*)(gbase) + (voff)[_i]), (PG8_LAS unsigned*)(lds + (bufoff) + ldsw + _i * 8192), 16, 0, 0); } while (0)
#define PG8_LDA(dst, b, h) do { _Pragma("unroll") for (int m = 0; m < 4; ++m) _Pragma("unroll") for (int k = 0; k < 2; ++k) dst[m][k] = *(const PG8_LAS bf16x8*)(lds + PG8_SA(b, h) + aoff + m * 2048 + k * 1024); } while (0)
#define PG8_LDB(dst, b, h) do { _Pragma("unroll") for (int n = 0; n < 2; ++n) _Pragma("unroll") for (int k = 0; k < 2; ++k) dst[n][k] = *(const PG8_LAS bf16x8*)(lds + PG8_SB(b, h) + boff + n * 2048 + k * 1024); } while (0)
#define PG8_MMA(ai, bj, At, Bt) do { __builtin_amdgcn_s_setprio(1); _Pragma("unroll") for (int m = 0; m < 4; ++m) _Pragma("unroll") for (int n = 0; n < 2; ++n) _Pragma("unroll") for (int k = 0; k < 2; ++k) \
        acc[ai][bj][m][n] = __builtin_amdgcn_mfma_f32_16x16x32_bf16(Bt[n][k], At[m][k], acc[ai][bj][m][n], 0, 0, 0); __builtin_amdgcn_s_setprio(0); } while (0)
#define PG8_WAIT_V(n) asm volatile("s_waitcnt vmcnt(" #n ")" ::: "memory")
#define PG8_WAIT_L(n) asm volatile("s_waitcnt lgkmcnt(" #n ")" ::: "memory")
#define PG8_BAR __builtin_amdgcn_s_barrier()
#define PG8_SCHED __builtin_amdgcn_sched_barrier(0)
    Unit cur, nxt; int ui = 0;
    if (!S.next(0, cur)) return;
    f32x4 acc[2][2][4][2];
#pragma unroll
    for (int a = 0; a < 2; ++a)
#pragma unroll
        for (int b = 0; b < 2; ++b)
#pragma unroll
            for (int m = 0; m < 4; ++m)
#pragma unroll
                for (int n = 0; n < 2; ++n) acc[a][b][m][n] = (f32x4){0.f, 0.f, 0.f, 0.f};
    bf16x8 At[4][2], B0[2][2], B1[2][2];
    const char* cA = (const char*)g.A + (size_t)cur.pm * tstepA + (size_t)(cur.pn / g.grp_div) * g.grp_a_off + (size_t)cur.kofs * 2; const char* cB = (const char*)g.Bt + (size_t)cur.pn * tstepB + (size_t)cur.kofs * 2;
    S.a_ready(cur);
    if constexpr (SP2) {
        PG8_STAGE(PG8_SB(0, 0), cB, voffB); PG8_STAGE(PG8_SB(0, 1), cB + hstepB, voffB); PG8_STAGE(PG8_SA(0, 0), cA, voffA); PG8_STAGE(PG8_SA(0, 1), cA + hstepA, voffA);
        if (wr == 1) PG8_BAR;
        PG8_WAIT_V(2); PG8_BAR;
        PG8_STAGE(PG8_SB(1, 0), cB + kstep, voffB); PG8_STAGE(PG8_SA(1, 0), cA + kstep, voffA); PG8_STAGE(PG8_SB(1, 1), cB + hstepB + kstep, voffB);
        PG8_WAIT_V(6); PG8_BAR;
    } else {
        PG8_STAGE(PG8_SB(0, 0), cB, voffB); PG8_STAGE(PG8_SA(0, 0), cA, voffA); PG8_STAGE(PG8_SB(0, 1), cB + hstepB, voffB); PG8_STAGE(PG8_SA(0, 1), cA + hstepA, voffA);
        if (wr == 1) PG8_BAR;
        PG8_WAIT_V(4); PG8_BAR;
        PG8_STAGE(PG8_SB(1, 0), cB + kstep, voffB); PG8_STAGE(PG8_SA(1, 0), cA + kstep, voffA); PG8_STAGE(PG8_SB(1, 1), cB + hstepB + kstep, voffB);
        PG8_WAIT_V(6); PG8_BAR;
    }
    for (;;) {
        const bool has_next = S.next(ui + 1, nxt);
        const char* nA = has_next ? (const char*)g.A + (size_t)nxt.pm * tstepA + (size_t)(nxt.pn / g.grp_div) * g.grp_a_off + (size_t)nxt.kofs * 2 : cA; const char* nB = has_next ? (const char*)g.Bt + (size_t)nxt.pn * tstepB + (size_t)nxt.kofs * 2 : cB;
        const int nt = cur.nt;
        for (int t = 0; t < nt; t += 2) {
            const bool last = (t == nt - 2);
            const char* a1 = cA + (size_t)(t + 1) * kstep;
            const char* a2 = last ? nA : cA + (size_t)(t + 2) * kstep; const char* b2 = last ? nB : cB + (size_t)(t + 2) * kstep;
            const char* a3 = a2 + kstep; const char* b3 = b2 + kstep;
            if (last && has_next) S.a_ready(nxt);
            if constexpr (SP2) {
            PG8_LDB(B0, 0, 0); PG8_LDB(B1, 0, 1); PG8_SCHED; PG8_LDA(At, 0, 0); PG8_STAGE(PG8_SA(1, 1), a1 + hstepA, voffA);
            PG8_WAIT_V(8); PG8_WAIT_L(0); PG8_BAR; PG8_MMA(0, 0, At, B0); PG8_MMA(0, 1, At, B1); PG8_BAR; PG8_SCHED;
            PG8_LDA(At, 0, 1); PG8_STAGE(PG8_SB(0, 0), b2, voffB); PG8_STAGE(PG8_SB(0, 1), b2 + hstepB, voffB); PG8_STAGE(PG8_SA(0, 0), a2, voffA);
            PG8_WAIT_V(8); PG8_WAIT_L(0); PG8_BAR; PG8_MMA(1, 0, At, B0); PG8_MMA(1, 1, At, B1); PG8_BAR; PG8_SCHED;
            PG8_LDB(B0, 1, 0); PG8_LDB(B1, 1, 1); PG8_SCHED; PG8_LDA(At, 1, 0); PG8_STAGE(PG8_SA(0, 1), a2 + hstepA, voffA);
            PG8_WAIT_V(8); PG8_WAIT_L(0); PG8_BAR; PG8_MMA(0, 0, At, B0); PG8_MMA(0, 1, At, B1); PG8_BAR; PG8_SCHED;
            PG8_LDA(At, 1, 1); PG8_STAGE(PG8_SB(1, 0), b3, voffB); PG8_STAGE(PG8_SB(1, 1), b3 + hstepB, voffB); PG8_STAGE(PG8_SA(1, 0), a3, voffA);
            PG8_WAIT_V(8); PG8_WAIT_L(0); PG8_BAR; PG8_MMA(1, 0, At, B0); PG8_MMA(1, 1, At, B1); PG8_BAR; PG8_SCHED;
            } else {
            PG8_LDB(B0, 0, 0); PG8_SCHED; PG8_LDA(At, 0, 0); PG8_STAGE(PG8_SA(1, 1), a1 + hstepA, voffA);
            PG8_WAIT_L(8); PG8_BAR; PG8_WAIT_L(0); PG8_MMA(0, 0, At, B0); PG8_BAR; PG8_SCHED;
            PG8_LDB(B1, 0, 1); PG8_STAGE(PG8_SB(0, 0), b2, voffB);
            PG8_BAR; PG8_WAIT_L(0); PG8_MMA(0, 1, At, B1); PG8_BAR;
            PG8_LDA(At, 0, 1); PG8_STAGE(PG8_SA(0, 0), a2, voffA);
            PG8_BAR; PG8_WAIT_L(0); PG8_MMA(1, 0, At, B0); PG8_BAR; PG8_SCHED;
            PG8_STAGE(PG8_SB(0, 1), b2 + hstepB, voffB);
            PG8_WAIT_V(6); PG8_BAR; PG8_MMA(1, 1, At, B1); PG8_BAR;
            PG8_LDB(B0, 1, 0); PG8_SCHED; PG8_LDA(At, 1, 0); PG8_STAGE(PG8_SA(0, 1), a2 + hstepA, voffA);
            PG8_WAIT_L(8); PG8_BAR; PG8_WAIT_L(0); PG8_MMA(0, 0, At, B0); PG8_BAR; PG8_SCHED;
            PG8_LDB(B1, 1, 1); PG8_STAGE(PG8_SB(1, 0), b3, voffB);
            PG8_BAR; PG8_WAIT_L(0); PG8_MMA(0, 1, At, B1); PG8_BAR;
            PG8_LDA(At, 1, 1); PG8_STAGE(PG8_SA(1, 0), a3, voffA);
            PG8_BAR; PG8_WAIT_L(0); PG8_MMA(1, 0, At, B0); PG8_BAR; PG8_SCHED;
            PG8_STAGE(PG8_SB(1, 1), b3 + hstepB, voffB);
            PG8_WAIT_V(6); PG8_BAR; PG8_MMA(1, 1, At, B1); PG8_BAR;
            }
        }
        if constexpr (ALIGN_EPI) { if (wr == 0) PG8_BAR; }
        if constexpr (!Epi::AFTER_DRAIN) { E(acc, cur, wr, wc, fr, fq); S.done(cur); }
        if (!has_next) break;
#pragma unroll
        for (int a = 0; a < 2; ++a)
#pragma unroll
            for (int b = 0; b < 2; ++b)
#pragma unroll
                for (int m = 0; m < 4; ++m)
#pragma unroll
                    for (int n = 0; n < 2; ++n) acc[a][b][m][n] = (f32x4){0.f, 0.f, 0.f, 0.f};
        cur = nxt; cA = nA; cB = nB; ++ui;
        if constexpr (ALIGN_EPI) { if (wr == 1) PG8_BAR; }
    }
    PG8_WAIT_V(0);
    if constexpr (!ALIGN_EPI) { if (wr == 0) PG8_BAR; }
    PG8_BAR;
    if constexpr (Epi::AFTER_DRAIN) { E.fused(acc, cur, wr, wc, fr, fq, lds, wid, lane); S.done(cur); }
#undef PG8_SA
#undef PG8_SB
#undef PG8_STAGE
#undef PG8_LDA
#undef PG8_LDB
#undef PG8_MMA
#undef PG8_WAIT_V
#undef PG8_WAIT_L
#undef PG8_BAR
#undef PG8_SCHED
}
}
#define GAS __attribute__((address_space(1)))
#define LAS __attribute__((address_space(3)))
typedef unsigned short bf16;
typedef unsigned v4u __attribute__((ext_vector_type(4)));
typedef float f32x4 __attribute__((ext_vector_type(4)));
typedef short bf16x8 __attribute__((ext_vector_type(8)));
typedef GAS unsigned gu32;
typedef GAS unsigned long long gu64;
#define RLX_AGENT __ATOMIC_RELAXED, __HIP_MEMORY_SCOPE_AGENT
#define LDS_WAIT() asm volatile("s_waitcnt lgkmcnt(0)" ::: "memory")
#define VM_WAIT() asm volatile("s_waitcnt vmcnt(0)" ::: "memory")
__device__ __forceinline__ unsigned long long rt() { return __builtin_amdgcn_s_memrealtime(); }
__device__ __forceinline__ unsigned f2bf(float f) { unsigned u = __builtin_bit_cast(unsigned, f); return (u + 0x7fffu + ((u >> 16) & 1u)) >> 16; }
__device__ __forceinline__ unsigned pk2(float lo, float hi) { return pg8::cvt_pk_bf16(lo, hi); }

#define XB_TMO      128
#define XB_XCNT(j)  (256  + 64 * (j))
#define XB_XSUB(j)  (1280 + 64 * (j))
#define XB_XGEN(j)  (2304 + 64 * (j))
#define XB_TOP      3328
#define XB_TOPGEN   3392
#define XCD_BAR_WORDS 3456
#define XB_SPIN_CAP (1u << 18)

__device__ __forceinline__ unsigned xb_ld(unsigned* p)              { return __hip_atomic_load(p, __ATOMIC_RELAXED, __HIP_MEMORY_SCOPE_AGENT); }
__device__ __forceinline__ unsigned xb_add(unsigned* p, unsigned v) { return __hip_atomic_fetch_add(p, v, __ATOMIC_RELAXED, __HIP_MEMORY_SCOPE_AGENT); }
__device__ __forceinline__ unsigned xb_xcc_id() { return (unsigned)__builtin_amdgcn_s_getreg((3 << 11) | 20) & 0xFu; }
#define XB_SPIN(cond, bar) do { unsigned _sp = 0; while (cond) { __builtin_amdgcn_s_sleep(1); \
    if ((++_sp & 255u) == 0u) { if (xb_ld(&(bar)[XB_TMO])) break; if (_sp > XB_SPIN_CAP) { atomicAdd(&(bar)[XB_TMO], 1u); break; } } } } while (0)

struct XcdBarrier {
    unsigned* bar; unsigned x;
    volatile LAS unsigned* st;
};

__device__ __forceinline__ XcdBarrier xcd_barrier_post(unsigned* bar, volatile LAS unsigned* st) {
    XcdBarrier b; b.bar = bar; b.x = xb_xcc_id(); b.st = st;
    if (threadIdx.x == 0) (void)xb_add(&bar[XB_XCNT(b.x)], 1u);
    return b;
}
__device__ __forceinline__ void xcd_barrier_complete(unsigned* bar, unsigned x, unsigned& nloc, unsigned& nx) {
    const unsigned G = gridDim.x * gridDim.y * gridDim.z;
    unsigned sum, cnt, mine, sp = 0u;
    for (;;) {
        sum = 0u; cnt = 0u; mine = 0u;
#pragma unroll
        for (unsigned j = 0; j < 16; ++j) { const unsigned c = xb_ld(&bar[XB_XCNT(j)]); sum += c; cnt += (c > 0u) ? 1u : 0u; mine = (j == x) ? c : mine; }
        if (sum == G) break;
        __builtin_amdgcn_s_sleep(1);
        if ((++sp & 255u) == 0u) { if (xb_ld(&bar[XB_TMO])) break; if (sp > XB_SPIN_CAP) { atomicAdd(&bar[XB_TMO], 1u); break; } }
    }
    nloc = mine > 0u ? mine : 1u; nx = cnt > 0u ? cnt : 1u;
}

__device__ __forceinline__ void xcd_barrier(const XcdBarrier& b) {
    asm volatile("s_waitcnt vmcnt(0)" ::: "memory");
    __syncthreads();
    if (threadIdx.x == 0) {
        unsigned* bar = b.bar;
        __builtin_amdgcn_s_waitcnt(0);
        unsigned nloc = b.st[0], nx = b.st[1];
        if (nloc == 0u) { xcd_barrier_complete(bar, b.x, nloc, nx); b.st[0] = nloc; b.st[1] = nx; }
        const unsigned old = xb_add(&bar[XB_XSUB(b.x)], 1u);
        const unsigned gen = old / nloc;
        if (old + 1u == (gen + 1u) * nloc) {
            __builtin_amdgcn_fence(__ATOMIC_RELEASE, "agent");
            asm volatile("s_waitcnt vmcnt(0)" ::: "memory");
            const unsigned og = xb_add(&bar[XB_TOP], 1u);
            const unsigned tg = og / nx;
            if (og + 1u == (tg + 1u) * nx) xb_add(&bar[XB_TOPGEN], 1u);
            else XB_SPIN(xb_ld(&bar[XB_TOPGEN]) == tg, bar);
            __builtin_amdgcn_fence(__ATOMIC_ACQUIRE, "agent");
            xb_add(&bar[XB_XGEN(b.x)], 1u);
            asm volatile("s_waitcnt vmcnt(0)" ::: "memory");
        } else {
            XB_SPIN(xb_ld(&bar[XB_XGEN(b.x)]) == gen, bar);
            __builtin_amdgcn_fence(__ATOMIC_ACQUIRE, "agent");
            asm volatile("s_waitcnt vmcnt(0)" ::: "memory");
        }
    }
    __syncthreads();
}


constexpr int NWAVES = 8;
constexpr int D = 2048, MP = 8192, MS = 1024, M = MP + MS;
constexpr int NSQ = 128, LS = 8;
constexpr int NH = 4, DK = 256, DV = 512, DQK = 1024;
constexpr int NIN = 11280, NINP = 11520, DFF = 5632, NGU = 11264, DPOOL = 1024, NADA = 12288, NMOD = 2 * NADA;
constexpr int C_Q = 0, C_K = 1024, C_V = 2048, C_OG = 4096, C_U = 6144, C_GA = 7168, C_GB = 9216, C_ALR = 11264;
constexpr float EPS = 1e-6f;
constexpr size_t PL = (size_t)M * 256;
#define P_Q(row, h) ((size_t)(h) * PL + (size_t)(row) * 256)
#define P_K(row, h) ((size_t)(4 + (h)) * PL + (size_t)(row) * 256)
#define P_V(row, h) ((size_t)(8 + 2 * (h)) * PL + (size_t)(row) * 512)
#define P_OG(row, h) ((size_t)(16 + 2 * (h)) * PL + (size_t)(row) * 512)
#define P_U(row, g) ((size_t)(24 + (g)) * PL + (size_t)(row) * 256)
#define P_GA(row, h) ((size_t)(28 + 2 * (h)) * PL + (size_t)(row) * 512)
#define P_GB(row, h) ((size_t)(36 + 2 * (h)) * PL + (size_t)(row) * 512)
#define P_ALR(row) ((size_t)44 * PL + (size_t)(row) * 256)
constexpr size_t OUT_Y = 0, OUT_GLAP = (size_t)M * D, OUT_POOLP = OUT_GLAP + 2ull * 4 * 4 * 256 * 512, OUT_GLAS = OUT_POOLP + 2ull * 4 * 15 * 1024,
                 OUT_POOLS = OUT_GLAS + 2ull * 128 * 4 * 256 * 512, OUT_END = OUT_POOLS + 2ull * 128 * 15 * 1024;
constexpr size_t MiB = 1u << 20;
constexpr size_t WS_CTL = 0, CTL_ZERO_BYTES = 64 * 1024;
constexpr size_t WS_WADA = 1 * MiB;
constexpr size_t WS_WIN = WS_WADA + 96 * MiB;
constexpr size_t WS_WO = WS_WIN + 2 * 45 * MiB;
constexpr size_t WS_WGU = WS_WO + 2 * 8 * MiB;
constexpr size_t WS_WDN = WS_WGU + 2 * 44 * MiB;
constexpr size_t WS_WPL = WS_WDN + 2 * 22 * MiB;
constexpr size_t WS_AC = WS_WPL + 2 * 1 * MiB;
constexpr size_t WS_MOD = WS_AC + 1 * MiB;
constexpr size_t WS_XN = WS_MOD + 24 * MiB;
constexpr size_t WS_P = WS_XN + 36 * MiB;
constexpr size_t WS_QE = WS_P + 203 * MiB;
constexpr size_t WS_KDT = WS_QE + 16 * MiB;
constexpr size_t WS_VT = WS_KDT + 16 * MiB;
constexpr size_t WS_ATT = WS_VT + 32 * MiB;
constexpr size_t WS_DEC = WS_ATT + 4 * MiB;
constexpr size_t WS_QES = WS_DEC + 1 * MiB;
constexpr size_t WS_KDS = WS_QES + 4 * MiB;
constexpr size_t WS_DECS = WS_KDS + 4 * MiB;
constexpr size_t WS_ATTS = WS_DECS + 1 * MiB;
constexpr size_t WS_DM = WS_ATTS + 1 * MiB;
constexpr size_t WS_O = WS_DM + 18 * MiB;
constexpr size_t WS_YB = WS_O + 36 * MiB;
constexpr size_t WS_MG = WS_YB + 36 * MiB;
constexpr size_t WS_X1 = WS_MG + 36 * MiB;
constexpr size_t WS_X2 = WS_X1 + 72 * MiB;
constexpr size_t WS_ACT = WS_X2 + 72 * MiB;
constexpr size_t WS_SLAB = WS_ACT + 99 * MiB;
constexpr size_t WS_END = WS_SLAB + 64 * MiB;
constexpr int CW_GLAQ = 2048;
constexpr int CW_BAR = 4096;
static_assert((CW_BAR + XCD_BAR_WORDS) * 4 <= (int)CTL_ZERO_BYTES && (CW_GLAQ + 128) * 4 <= (int)CTL_ZERO_BYTES, "CTL");
constexpr int LDS_BYTES = 163840;
constexpr int MISC_OFF = LDS_BYTES - 256;

struct Frame {
    LAS unsigned char* lds; volatile LAS unsigned* MISC; gu32* ctl;
    int tid, lane, wave, vcu, G;
    const float *xP, *xS, *stG, *stP, *cP, *cS, *w_ada, *b_ada, *norm1_g, *w_in, *w_a2, *b_a, *gla_norm_g, *w_pool, *pool_scale, *w_o, *norm2_g, *w_gu, *w_down, *final_g;
    float* out; unsigned char* ws;
};
__device__ __forceinline__ float wave_sum(float v) {
#pragma unroll
    for (int o = 1; o < 64; o <<= 1) v += __shfl_xor(v, o);
    return v;
}
__device__ __forceinline__ float bf2f(unsigned short b) { return __builtin_bit_cast(float, (unsigned)b << 16); }
__device__ __forceinline__ float bflo(unsigned w) { return __builtin_bit_cast(float, w << 16); }
__device__ __forceinline__ float bfhi(unsigned w) { return __builtin_bit_cast(float, w & 0xffff0000u); }
__device__ __forceinline__ float sigmoidf_(float x) { return 1.0f / (1.0f + __expf(-x)); }
__device__ __forceinline__ int seq_of_row(int r) { return r < MP ? (r >> 11) : 4 + ((r - MP) >> 3); }

template <int MODE>
__device__ __forceinline__ void conv_tile_ld(const float* W, int Nsrc, int k0, int n0, int lane, f32x4 (&v)[16]) {
    const int c = lane & 15, g = lane >> 4, n = n0 + 4 * c;
    const bool ok = n < Nsrc;
#pragma unroll
    for (int j = 0; j < 16; ++j) v[j] = ok ? *(const GAS f32x4*)(W + (size_t)(k0 + 32 * (j >> 3) + 8 * g + (j & 7)) * Nsrc + n) : (f32x4){0.f, 0.f, 0.f, 0.f};
}
template <int MODE>
__device__ __forceinline__ void conv_tile_st(bf16* WT, int ldk, int k0, int n0, int lane, const f32x4 (&v)[16]) {
    const int c = lane & 15, g = lane >> 4, n = n0 + 4 * c;
    int dr = n;
    if (MODE == 1) dr = (n < DFF) ? 256 * (n >> 7) + (n & 127) : 256 * ((n - DFF) >> 7) + 128 + ((n - DFF) & 127);
#pragma unroll
    for (int i = 0; i < 4; ++i)
#pragma unroll
        for (int hk = 0; hk < 2; ++hk) { v4u o; o.x = pk2(v[8 * hk + 0][i], v[8 * hk + 1][i]); o.y = pk2(v[8 * hk + 2][i], v[8 * hk + 3][i]); o.z = pk2(v[8 * hk + 4][i], v[8 * hk + 5][i]); o.w = pk2(v[8 * hk + 6][i], v[8 * hk + 7][i]);
            *(GAS v4u*)(WT + (size_t)(dr + i) * ldk + k0 + 32 * hk + 8 * g) = o; }
}
template <int MODE>
__device__ __forceinline__ void conv_matrix(const float* W, int K, int Nsrc, int Npad, bf16* WT, int gw, int NGW, int lane) {
    const int nb = Npad / 64, ntile = (K / 64) * nb;
    f32x4 va[16], vb[16];
    int t = gw;
    if (t < ntile) conv_tile_ld<MODE>(W, Nsrc, (t / nb) * 64, (t % nb) * 64, lane, va);
#pragma unroll 1
    for (; t < ntile; t += 2 * NGW) {
        const int t1 = t + NGW, t2 = t + 2 * NGW;
        if (t1 < ntile) conv_tile_ld<MODE>(W, Nsrc, (t1 / nb) * 64, (t1 % nb) * 64, lane, vb);
        conv_tile_st<MODE>(WT, K, (t / nb) * 64, (t % nb) * 64, lane, va);
        if (t2 < ntile) conv_tile_ld<MODE>(W, Nsrc, (t2 / nb) * 64, (t2 % nb) * 64, lane, va);
        if (t1 < ntile) conv_tile_st<MODE>(WT, K, (t1 / nb) * 64, (t1 % nb) * 64, lane, vb);
    }
}
enum { CV_ADA = 1, CV_IN = 2, CV_O = 4, CV_GU = 8, CV_DN = 16, CV_PL = 32 };
template <int WHICH>
__device__ __forceinline__ void conv_set(Frame& F, int l, int gw, int NGW) {
    unsigned char* ws = F.ws; const int lane = F.lane;
    if (WHICH & CV_ADA) conv_matrix<0>(F.w_ada + (size_t)l * D * NADA, D, NADA, NADA, (bf16*)(ws + WS_WADA) + (size_t)l * NADA * D, gw, NGW, lane);
    if (WHICH & CV_IN) conv_matrix<0>(F.w_in + (size_t)l * D * NIN, D, NIN, NINP, (bf16*)(ws + WS_WIN + (size_t)l * 45 * MiB), gw, NGW, lane);
    if (WHICH & CV_PL) {
#pragma unroll 1
        for (int g = 0; g < 4; ++g)
            conv_matrix<0>(F.w_pool + (size_t)(l * 4 + g) * 256 * 512, 256, 512, 512, (bf16*)(ws + WS_WPL + (size_t)l * 1 * MiB) + (size_t)g * 512 * 256, gw, NGW, lane);
    }
    if (WHICH & CV_O) conv_matrix<0>(F.w_o + (size_t)l * D * D, D, D, D, (bf16*)(ws + WS_WO + (size_t)l * 8 * MiB), gw, NGW, lane);
    if (WHICH & CV_GU) conv_matrix<1>(F.w_gu + (size_t)l * D * NGU, D, NGU, NGU, (bf16*)(ws + WS_WGU + (size_t)l * 44 * MiB), gw, NGW, lane);
    if (WHICH & CV_DN) conv_matrix<0>(F.w_down + (size_t)l * DFF * D, DFF, D, D, (bf16*)(ws + WS_WDN + (size_t)l * 22 * MiB), gw, NGW, lane);
}
template <int WHICH>
__device__ __forceinline__ void conv_in_tail(Frame& F, int l, int nwg) {
    const int R = nwg % F.G, c = (int)blockIdx.x;
    if (c >= R) conv_set<WHICH>(F, l, (c - R) * NWAVES + F.wave, (F.G - R) * NWAVES);
}
__device__ __forceinline__ void p0_convert(Frame& F) {
    unsigned char* ws = F.ws;
    bf16* AC = (bf16*)(ws + WS_AC);
    for (int i = (F.vcu * NWAVES * 64 + F.tid); i < 256 * D / 2; i += F.G * NWAVES * 64) {
        const int r = (2 * i) / D, c = (2 * i) % D; float a = 0.f, b = 0.f;
        if (r < 132) { const float* src = r < 4 ? F.cP + (size_t)r * D + c : F.cS + (size_t)(r - 4) * D + c; a = src[0]; b = src[1]; a = a * sigmoidf_(a); b = b * sigmoidf_(b); }
        *(GAS unsigned*)(AC + 2 * (size_t)i) = pk2(a, b);
    }
}
__device__ __forceinline__ void ada_direct(Frame& F) {
    const int cu = (int)blockIdx.x;
    if (cu >= 192) return;
    const bf16* AC = (const bf16*)(F.ws + WS_AC); float* MOD = (float*)(F.ws + WS_MOD);
    const int lane = F.lane, wave = F.wave, c = lane & 15, g = lane >> 4;
    const int ng = cu * 2 + (wave & 1), kh = (wave >> 1) & 1, mh = wave >> 2, l = ng / 192, n0 = (ng % 192) * 64;
    const float* W = F.w_ada + (size_t)l * D * NADA + n0 + 4 * c + (size_t)(kh * 1024 + 8 * g) * NADA;
    const bf16* Ap = AC + (size_t)(80 * mh + c) * D + kh * 1024 + 8 * g;
    f32x4 acc[5][4];
#pragma unroll
    for (int mt = 0; mt < 5; ++mt)
#pragma unroll
        for (int i = 0; i < 4; ++i) acc[mt][i] = (f32x4){0.f, 0.f, 0.f, 0.f};
    f32x4 v[3][8]; bf16x8 Af[5], An[5];
#define ADA_LD(sl, ks_) do { _Pragma("unroll") for (int j = 0; j < 8; ++j) v[sl][j] = *(const GAS f32x4*)(W + (size_t)(32 * (ks_) + j) * NADA); } while (0)
    ADA_LD(0, 0); ADA_LD(1, 1);
#pragma unroll
    for (int mt = 0; mt < 5; ++mt) Af[mt] = *(const GAS bf16x8*)(Ap + (size_t)mt * 16 * D);
#pragma unroll 1
    for (int ks3 = 0; ks3 < 33; ks3 += 3) {
#pragma unroll
        for (int u = 0; u < 3; ++u) { const int ks = ks3 + u;
            if (ks < 32) {
                if (ks + 2 < 32) ADA_LD((u + 2) % 3, ks + 2);
                if (ks + 1 < 32) {
#pragma unroll
                    for (int mt = 0; mt < 5; ++mt) An[mt] = *(const GAS bf16x8*)(Ap + (size_t)mt * 16 * D + 32 * (ks + 1)); }
                bf16x8 Bf[4];
#pragma unroll
                for (int i = 0; i < 4; ++i) { const v4u pk = {pk2(v[u][0][i], v[u][1][i]), pk2(v[u][2][i], v[u][3][i]), pk2(v[u][4][i], v[u][5][i]), pk2(v[u][6][i], v[u][7][i])}; Bf[i] = __builtin_bit_cast(bf16x8, pk); }
#pragma unroll
                for (int mt = 0; mt < 5; ++mt)
#pragma unroll
                    for (int i = 0; i < 4; ++i) acc[mt][i] = __builtin_amdgcn_mfma_f32_16x16x32_bf16(Af[mt], Bf[i], acc[mt][i], 0, 0, 0);
#pragma unroll
                for (int mt = 0; mt < 5; ++mt) Af[mt] = An[mt];
            } }
    }
#undef ADA_LD
    LAS float* red = (LAS float*)F.lds + ((wave & 1) + 2 * mh) * (80 * 64);
    if (kh == 1) {
#pragma unroll
        for (int mt = 0; mt < 5; ++mt)
#pragma unroll
            for (int i = 0; i < 4; ++i)
#pragma unroll
                for (int r = 0; r < 4; ++r) red[((mt * 4 + i) * 4 + r) * 64 + lane] = acc[mt][i][r]; }
    __syncthreads();
    if (kh == 0) {
        const f32x4 bias = *(const GAS f32x4*)(F.b_ada + (size_t)l * NADA + n0 + 4 * c);
#pragma unroll
        for (int mt = 0; mt < 5; ++mt)
#pragma unroll
            for (int r = 0; r < 4; ++r) { f32x4 o;
#pragma unroll
                for (int i = 0; i < 4; ++i) o[i] = acc[mt][i][r] + red[((mt * 4 + i) * 4 + r) * 64 + lane] + bias[i];
                *(GAS f32x4*)(MOD + (size_t)(80 * mh + 16 * mt + 4 * g + r) * NMOD + (size_t)l * NADA + n0 + 4 * c) = o; }
    }
    __syncthreads();
}
__device__ __forceinline__ void norm_rows(Frame& F, const float* srcP, const float* srcS, const float* gain, const float* sh_base  , bf16* XN,
                                          const bf16* rslab, const float* rbase, const float* rgate, float* xout) {
    const int gw = F.vcu * NWAVES + F.wave, NGW = F.G * NWAVES;
    f32x4 vn[8];
    { const int r = gw; if (r < M && !(rslab != nullptr && r >= MP)) { const GAS f32x4* xr = (const GAS f32x4*)(r < MP ? srcP + (size_t)r * D : srcS + (size_t)(r - MP) * D) + F.lane;
#pragma unroll
        for (int j = 0; j < 8; ++j) vn[j] = xr[64 * j]; } }
    for (int r = gw; r < M; r += NGW) {
        f32x4 v[8]; float s = 0.f;
        if (rslab != nullptr && r >= MP) {
            const GAS f32x4* bp = (const GAS f32x4*)(rbase + (size_t)(r - MP) * D) + F.lane; const GAS f32x4* gp = (const GAS f32x4*)(rgate + (size_t)seq_of_row(r) * NMOD) + F.lane;
            GAS f32x4* xo = (GAS f32x4*)(xout + (size_t)r * D) + F.lane;
#pragma unroll
            for (int j = 0; j < 8; ++j) { f32x4 a = {0.f, 0.f, 0.f, 0.f};
#pragma unroll
                for (int sl = 0; sl < 8; ++sl) { typedef unsigned u32x2 __attribute__((ext_vector_type(2))); const u32x2 w = *((const GAS u32x2*)(rslab + ((size_t)sl * MS + (r - MP)) * D) + F.lane + 64 * j); a += (f32x4){bflo(w.x), bfhi(w.x), bflo(w.y), bfhi(w.y)}; }
                v[j] = bp[64 * j] + gp[64 * j] * a; xo[64 * j] = v[j]; if (j & 1) asm volatile("" ::: "memory"); }
        } else {
#pragma unroll
            for (int j = 0; j < 8; ++j) v[j] = vn[j];
        }
        { const int rn = r + NGW; if (rn < M && !(rslab != nullptr && rn >= MP)) { const GAS f32x4* xr = (const GAS f32x4*)(rn < MP ? srcP + (size_t)rn * D : srcS + (size_t)(rn - MP) * D) + F.lane;
#pragma unroll
            for (int j = 0; j < 8; ++j) vn[j] = xr[64 * j]; } }
#pragma unroll
        for (int j = 0; j < 8; ++j) s += (v[j].x * v[j].x + v[j].y * v[j].y) + (v[j].z * v[j].z + v[j].w * v[j].w);
        const float rstd = 1.0f / sqrtf(wave_sum(s) * (1.0f / D) + EPS);
        const float* sh = sh_base + (size_t)seq_of_row(r) * NMOD; const float* sc = sh + D;
        GAS unsigned long long* o8 = (GAS unsigned long long*)(XN + (size_t)r * D) + F.lane;
#pragma unroll
        for (int j = 0; j < 8; ++j) { const int c = 4 * (F.lane + 64 * j);
            const f32x4 g4 = *(const GAS f32x4*)(gain + c), s4 = *(const GAS f32x4*)(sh + c), c4 = *(const GAS f32x4*)(sc + c);
            const f32x4 o = v[j] * rstd * g4 * (c4 + 1.0f) + s4;
            o8[64 * j] = (unsigned long long)pk2(o.x, o.y) | ((unsigned long long)pk2(o.z, o.w) << 32); }
    }
}
__device__ __forceinline__ void final_norm(Frame& F, const float* src, const bf16* rslab, const float* rbase, const float* rgate) {
    const int gw = F.vcu * NWAVES + F.wave, NGW = F.G * NWAVES;
    for (int r = gw; r < M; r += NGW) {
        f32x4 v[8]; float s = 0.f;
        if (r >= MP) {
            const GAS f32x4* bp = (const GAS f32x4*)(rbase + (size_t)(r - MP) * D) + F.lane; const GAS f32x4* gp = (const GAS f32x4*)(rgate + (size_t)seq_of_row(r) * NMOD) + F.lane;
#pragma unroll
            for (int j = 0; j < 8; ++j) { f32x4 a = {0.f, 0.f, 0.f, 0.f};
#pragma unroll
                for (int sl = 0; sl < 8; ++sl) { typedef unsigned u32x2 __attribute__((ext_vector_type(2))); const u32x2 w = *((const GAS u32x2*)(rslab + ((size_t)sl * MS + (r - MP)) * D) + F.lane + 64 * j); a += (f32x4){bflo(w.x), bfhi(w.x), bflo(w.y), bfhi(w.y)}; }
                v[j] = bp[64 * j] + gp[64 * j] * a; if (j & 1) asm volatile("" ::: "memory"); }
        } else {
            const GAS f32x4* xr = (const GAS f32x4*)(src + (size_t)r * D) + F.lane;
#pragma unroll
            for (int j = 0; j < 8; ++j) v[j] = xr[64 * j];
        }
#pragma unroll
        for (int j = 0; j < 8; ++j) s += (v[j].x * v[j].x + v[j].y * v[j].y) + (v[j].z * v[j].z + v[j].w * v[j].w);
        const float rstd = 1.0f / sqrtf(wave_sum(s) * (1.0f / D) + EPS);
        GAS f32x4* o = (GAS f32x4*)(F.out + OUT_Y + (size_t)r * D) + F.lane;
#pragma unroll
        for (int j = 0; j < 8; ++j) { const f32x4 g4 = *(const GAS f32x4*)(F.final_g + 4 * (F.lane + 64 * j)); o[64 * j] = v[j] * rstd * g4; }
    }
}
__device__ __forceinline__ float logsigmoid_(float x) { return fminf(x, 0.f) - __logf(1.0f + __expf(-fabsf(x))); }
__device__ __forceinline__ void prep_phase(Frame& F, int l) {
    unsigned char* ws = F.ws;
    const bf16* P = (const bf16*)(ws + WS_P);
    bf16* QE = (bf16*)(ws + WS_QE); bf16* KDT = (bf16*)(ws + WS_KDT); bf16* VT = (bf16*)(ws + WS_VT); bf16* ATT = (bf16*)(ws + WS_ATT);
    float* DEC = (float*)(ws + WS_DEC); float* QES = (float*)(ws + WS_QES); float* KDS = (float*)(ws + WS_KDS); float* DECS = (float*)(ws + WS_DECS); float* ATTS = (float*)(ws + WS_ATTS);
    bf16* DM = (bf16*)(ws + WS_DM);
    LAS float* ALR = (LAS float*)(F.lds);
    LAS float* TOT = (LAS float*)(F.lds + 4096);
    LAS unsigned char* QEl = F.lds + 8192;
    LAS unsigned char* KEl = F.lds + 8192 + 33792;
    LAS unsigned char* Vl = F.lds + 8192;
    const int tid = F.tid, lane = F.lane, wave = F.wave, dk = tid & 255, hf = tid >> 8;
    for (int item = (int)blockIdx.x; item < 144 * 4; item += F.G) {
        const int rb = item >> 2, h = item & 3, r0 = rb * 64; const bool isS = rb >= 128;
        const int bseq = rb >> 5, tseq0 = (rb & 31) * 64;
        { const int t = tid >> 3, j2 = (tid & 7) * 2; const unsigned w = *(const GAS unsigned*)(P + P_ALR(r0 + t) + j2); ALR[t * 16 + j2] = bflo(w); ALR[t * 16 + j2 + 1] = bfhi(w); }
        float wcol[16];
#pragma unroll
        for (int j = 0; j < 16; ++j) wcol[j] = F.w_a2[(size_t)(l * 16 + j) * DQK + h * DK + dk];
        const float ba = F.b_a[(size_t)l * DQK + h * DK + dk];
        __syncthreads();
        float la[32];
#pragma unroll
        for (int tt = 0; tt < 32; ++tt) { const int t = 32 * hf + tt; float a = ba;
#pragma unroll
            for (int j4 = 0; j4 < 4; ++j4) { const f32x4 x = *(const LAS f32x4*)(ALR + t * 16 + 4 * j4); a += x.x * wcol[4 * j4] + x.y * wcol[4 * j4 + 1] + x.z * wcol[4 * j4 + 2] + x.w * wcol[4 * j4 + 3]; }
            la[tt] = logsigmoid_(a) * 0.0625f; }
        if (!isS) { float run = 0.f;
#pragma unroll
            for (int tt = 0; tt < 32; ++tt) { run += la[tt]; la[tt] = run; }
            TOT[hf * 256 + dk] = run;
        } else { float run = 0.f;
#pragma unroll
            for (int tt = 0; tt < 32; ++tt) { run = (tt & 7) ? run + la[tt] : la[tt]; la[tt] = run; } }
        __syncthreads();
        float off = 0.f, blast = 0.f;
        if (!isS) { const float t0 = TOT[dk], t1 = TOT[256 + dk]; off = hf ? t0 : 0.f; blast = t0 + t1; }
        unsigned kdp[16], qk[32];
#pragma unroll
        for (int tt = 0; tt < 32; ++tt) { const int rw = r0 + 32 * hf + tt; qk[tt] = (unsigned)P[P_Q(rw, h) + dk] | ((unsigned)P[P_K(rw, h) + dk] << 16); }
#pragma unroll
        for (int tt = 0; tt < 32; ++tt) { const int t = 32 * hf + tt, row = r0 + t;
            const float q = bflo(qk[tt]), k = bfhi(qk[tt]);
            const float b = la[tt] + off, bl = isS ? la[tt | 7] : blast;
            const float qe = q * 0.0625f * __expf(b), ke = k * __expf(-b), kd = k * __expf(bl - b);
            const unsigned short qb = (unsigned short)f2bf(qe), kb = (unsigned short)f2bf(ke);
            *(LAS unsigned short*)(QEl + t * 528 + dk * 2) = qb; *(LAS unsigned short*)(KEl + t * 528 + dk * 2) = kb;
            if (!isS) { QE[(size_t)row * DQK + h * DK + dk] = qb; const unsigned kdb = f2bf(kd); if (tt & 1) kdp[tt >> 1] |= kdb << 16; else kdp[tt >> 1] = kdb; }
            else { QES[(size_t)(row - MP) * DQK + h * DK + dk] = qe; KDS[(size_t)(row - MP) * DQK + h * DK + dk] = kd; } }
        if (!isS) {
            GAS v4u* dst = (GAS v4u*)(KDT + ((size_t)((bseq * 4 + h) * DK + dk)) * 2048 + tseq0 + 32 * hf);
#pragma unroll
            for (int i = 0; i < 4; ++i) dst[i] = (v4u){kdp[4 * i], kdp[4 * i + 1], kdp[4 * i + 2], kdp[4 * i + 3]};
            if (hf == 0) DEC[(size_t)(rb * 4 + h) * DK + dk] = __expf(blast);
        } else {
#pragma unroll
            for (int sg = 0; sg < 4; ++sg) DECS[(size_t)((rb - 128) * 8 + 4 * hf + sg) * DQK + h * DK + dk] = __expf(la[8 * sg + 7]);
        }
        __syncthreads();
        { const int mt = wave >> 1, nt0 = (wave & 1) * 2, c = lane & 15, g = lane >> 4;
            f32x4 a0 = {0.f, 0.f, 0.f, 0.f}, a1 = {0.f, 0.f, 0.f, 0.f};
#pragma unroll
            for (int kk = 0; kk < 8; ++kk) {
                const bf16x8 A = *(const LAS bf16x8*)(QEl + (16 * mt + c) * 528 + (32 * kk + 8 * g) * 2);
                const bf16x8 B0 = *(const LAS bf16x8*)(KEl + (16 * nt0 + c) * 528 + (32 * kk + 8 * g) * 2);
                const bf16x8 B1 = *(const LAS bf16x8*)(KEl + (16 * (nt0 + 1) + c) * 528 + (32 * kk + 8 * g) * 2);
                a0 = __builtin_amdgcn_mfma_f32_16x16x32_bf16(A, B0, a0, 0, 0, 0); a1 = __builtin_amdgcn_mfma_f32_16x16x32_bf16(A, B1, a1, 0, 0, 0); }
#pragma unroll
            for (int q = 0; q < 2; ++q) { const f32x4 a = q ? a1 : a0; const int s = 16 * (nt0 + q) + c;
#pragma unroll
                for (int i = 0; i < 4; ++i) { const int t = 16 * mt + 4 * g + i; const float v = (s <= t) ? a[i] : 0.f;
                    if (!isS) ATT[((size_t)(rb * 4 + h) * 64 + t) * 64 + s] = (unsigned short)f2bf(v);
                    else if ((t >> 3) == (s >> 3)) ATTS[(((size_t)((rb - 128) * 8 + (t >> 3)) * 4 + h) * 8 + (t & 7)) * 8 + (s & 7)] = v; } }
        }
        if (!isS) {
            __syncthreads();
#pragma unroll
            for (int i = 0; i < 8; ++i) { const int idx = i * 512 + tid, t = idx >> 6, ch = idx & 63;
                const v4u w = *(const GAS v4u*)(P + P_V(r0 + t, h) + ch * 8); *(LAS v4u*)(Vl + t * 1040 + ch * 16) = w; }
            __syncthreads();
            GAS v4u* dst = (GAS v4u*)(VT + ((size_t)((bseq * 4 + h) * DV + tid)) * 2048 + tseq0);
#pragma unroll
            for (int t8 = 0; t8 < 8; ++t8) { unsigned wd[4];
#pragma unroll
                for (int j = 0; j < 4; ++j) { const unsigned lo = *(const LAS unsigned short*)(Vl + (8 * t8 + 2 * j) * 1040 + tid * 2), hi = *(const LAS unsigned short*)(Vl + (8 * t8 + 2 * j + 1) * 1040 + tid * 2); wd[j] = lo | (hi << 16); }
                dst[t8] = (v4u){wd[0], wd[1], wd[2], wd[3]}; }
        }
        __syncthreads();
    }
}
template <int W>
__device__ __forceinline__ void pool_block(Frame& F, int l, int rblk, int g, int lane) {
    typedef unsigned u32x2 __attribute__((ext_vector_type(2)));
    const bf16* P = (const bf16*)(F.ws + WS_P); bf16* DM = (bf16*)(F.ws + WS_DM);
    const int r0 = rblk * 16, ch = 4 * lane;
    const float rw = 1.0f / (float)W;
    if (r0 < MP) {
        const int tq0 = r0 & 2047;
        u32x2 x[15 + W];
#pragma unroll
        for (int i = 0; i < 15 + W; ++i) { const int rr = r0 - (W - 1) + i; x[i] = (tq0 - (W - 1) + i >= 0) ? *(const GAS u32x2*)(P + P_U(rr, g) + ch) : (u32x2){0u, 0u}; }
        float s0 = 0.f, s1 = 0.f, s2 = 0.f, s3 = 0.f;
#pragma unroll
        for (int i = 0; i < W - 1; ++i) { s0 += bflo(x[i].x); s1 += bfhi(x[i].x); s2 += bflo(x[i].y); s3 += bfhi(x[i].y); }
#pragma unroll
        for (int i = 0; i < 16; ++i) { const u32x2 cu = x[i + W - 1]; const float u0 = bflo(cu.x), u1 = bfhi(cu.x), u2 = bflo(cu.y), u3 = bfhi(cu.y);
            s0 += u0; s1 += u1; s2 += u2; s3 += u3;
            const int tq = tq0 + i; const float rc = (tq + 1 >= W) ? rw : 1.0f / (float)(tq + 1);
            *(GAS u32x2*)(DM + (size_t)(r0 + i) * DPOOL + 256 * g + ch) = (u32x2){pk2(s0 * rc - u0, s1 * rc - u1), pk2(s2 * rc - u2, s3 * rc - u3)};
            const u32x2 ou = x[i]; s0 -= bflo(ou.x); s1 -= bfhi(ou.x); s2 -= bflo(ou.y); s3 -= bfhi(ou.y);
            if (tq >= 2033) *(GAS f32x4*)(F.out + OUT_POOLP + ((size_t)(l * 4 + (r0 >> 11)) * 15 + (tq - 2033)) * DPOOL + 256 * g + ch) = (f32x4){u0, u1, u2, u3}; }
    } else {
#pragma unroll
        for (int sq = 0; sq < 2; ++sq) { const int rs = r0 + 8 * sq, seq = (rs - MP) >> 3;
            const float* sp = F.stP + ((size_t)(l * NSQ + seq) * 15) * DPOOL + 256 * g + ch; float* op = F.out + OUT_POOLS + ((size_t)(l * NSQ + seq) * 15) * DPOOL + 256 * g + ch;
            f32x4 hst[15]; u32x2 x[8];
#pragma unroll
            for (int i = 0; i < 15; ++i) if (i >= 8 || i >= 15 - (W - 1)) hst[i] = *(const GAS f32x4*)(sp + (size_t)i * DPOOL);
#pragma unroll
            for (int i = 0; i < 8; ++i) x[i] = *(const GAS u32x2*)(P + P_U(rs + i, g) + ch);
#pragma unroll
            for (int i = 0; i < 7; ++i) *(GAS f32x4*)(op + (size_t)i * DPOOL) = hst[8 + i];
            f32x4 s = {0.f, 0.f, 0.f, 0.f};
#pragma unroll
            for (int i = 15 - (W - 1); i < 15; ++i) s += hst[i];
#pragma unroll
            for (int i = 0; i < 8; ++i) { const f32x4 u = {bflo(x[i].x), bfhi(x[i].x), bflo(x[i].y), bfhi(x[i].y)}; s += u;
                *(GAS u32x2*)(DM + (size_t)(rs + i) * DPOOL + 256 * g + ch) = (u32x2){pk2(s.x * rw - u.x, s.y * rw - u.y), pk2(s.z * rw - u.z, s.w * rw - u.w)};
                const int idx = 15 + i - (W - 1);
                if (idx >= 15) { const u32x2 ou = x[idx - 15 < 8 ? idx - 15 : 0]; s -= (f32x4){bflo(ou.x), bfhi(ou.x), bflo(ou.y), bfhi(ou.y)}; } else s -= hst[idx];
                *(GAS f32x4*)(op + (size_t)(7 + i) * DPOOL) = u; }
        }
    }
}
__device__ __forceinline__ void pool_rows(Frame& F, int l) {
    const int gw = F.vcu * NWAVES + F.wave, NGW = F.G * NWAVES, lane = F.lane;
#pragma unroll 1
    for (int it = gw; it < (M / 16) * 4; it += NGW) { const int g = it & 3, rblk = it >> 2;
        if (g == 0) pool_block<2>(F, l, rblk, 0, lane); else if (g == 1) pool_block<4>(F, l, rblk, 1, lane); else if (g == 2) pool_block<8>(F, l, rblk, 2, lane); else pool_block<16>(F, l, rblk, 3, lane);
    }
}
typedef float f32x16 __attribute__((ext_vector_type(16)));
constexpr int GQ_STR = 528, GK_STR = 144, GA_STR = 144, GBUF = 64 * GQ_STR + 256 * GK_STR + 64 * GA_STR + 1024;
static_assert(GBUF == 79 * 1024 && 2 * GBUF <= MISC_OFF, "gla LDS");
__device__ __forceinline__ void gla_stage_offsets(int hw, int lane, unsigned (&off)[20]) {
#pragma unroll
    for (int i = 0; i < 20; ++i) { const int p = hw + 4 * i, c = p * 64 + lane; unsigned o;
        if (p < 33) { const int row = c / 33, cc = c - row * 33; o = (unsigned)(row * DQK * 2 + (cc < 31 ? cc : 31) * 16); }
        else if (p < 69) { const int c2 = c - 33 * 64, row = c2 / 9, cc = c2 - row * 9; o = (unsigned)(row * 2048 * 2 + (cc < 7 ? cc : 7) * 16); }
        else if (p < 78) { const int c2 = c - 69 * 64, row = c2 / 9, cc = c2 - row * 9; o = (unsigned)(row * 64 * 2 + (cc < 7 ? cc : 7) * 16); }
        else o = (unsigned)(lane * 16);
        off[i] = o; }
}
__device__ __forceinline__ void gla_stage(LAS unsigned char* B, const bf16* QE, const bf16* KDT, const bf16* ATT, const float* DEC, int bseq, int h, int bh, int n, int hw, const unsigned (&off)[20]) {
    const int rbn = bseq * 32 + n, r0n = rbn * 64, ts = n * 64;
    const char* bq = (const char*)(QE + (size_t)r0n * DQK + h * DK); const char* bk = (const char*)(KDT + (size_t)(bh * DK) * 2048 + ts);
    const char* ba = (const char*)(ATT + (size_t)(rbn * 4 + h) * 4096); const char* bd = (const char*)(DEC + (size_t)(rbn * 4 + h) * DK);
#pragma unroll
    for (int i = 0; i < 20; ++i) { const int p = hw + 4 * i;
        if (p < 79) { const char* base = p < 33 ? bq : p < 69 ? bk : p < 78 ? ba : bd;
            __builtin_amdgcn_global_load_lds((const unsigned*)(base + off[i]), (LAS unsigned*)(B + p * 1024), 16, 0, 0); } }
}
__device__ __forceinline__ void gla_prompt(Frame& F, int l) {
    unsigned char* ws = F.ws;
    const bf16* QE = (const bf16*)(ws + WS_QE); const bf16* KDT = (const bf16*)(ws + WS_KDT); const bf16* VT = (const bf16*)(ws + WS_VT); const bf16* ATT = (const bf16*)(ws + WS_ATT);
    const float* DEC = (const float*)(ws + WS_DEC); bf16* O = (bf16*)(ws + WS_O); float* SSQ = (float*)(ws + WS_YB);
    typedef unsigned u32x2 __attribute__((ext_vector_type(2)));
    const int lane = F.lane, wave = F.wave, r = lane & 31, hh = lane >> 5;
    const int j = ((int)blockIdx.x & 7) * 8 + ((int)blockIdx.x >> 3), bseq = j >> 4, h = (j >> 2) & 3, bh = bseq * 4 + h, ec = (j & 3) * 128 + 32 * (wave & 3);
    const int NCH = 32 * (PROBE_DUP == 4 ? 2 : 1);
    if (wave >= 4) {
        unsigned soff[20]; gla_stage_offsets(wave - 4, lane, soff);
        gla_stage(F.lds, QE, KDT, ATT, DEC, bseq, h, bh, 0, wave - 4, soff);
        asm volatile("s_waitcnt vmcnt(0)" ::: "memory"); __builtin_amdgcn_s_barrier();
#pragma unroll 1
        for (int n_ = 0; n_ < NCH; ++n_) {
            if (n_ + 1 < NCH) gla_stage(F.lds + ((n_ + 1) & 1) * GBUF, QE, KDT, ATT, DEC, bseq, h, bh, (n_ + 1) & 31, wave - 4, soff);
            asm volatile("s_waitcnt vmcnt(0)" ::: "memory"); __builtin_amdgcn_s_barrier();
        }
    } else {
        f32x16 St[8];
#pragma unroll
        for (int i = 0; i < 8; ++i)
#pragma unroll
            for (int q = 0; q < 16; ++q) St[i][q] = 0.f;
        bf16x8 vA[4];
#pragma unroll
        for (int kk = 0; kk < 4; ++kk) vA[kk] = *(const GAS bf16x8*)(VT + ((size_t)(bh * DV + ec + r)) * 2048 + 16 * kk + 8 * hh);
        __builtin_amdgcn_s_barrier(); asm volatile("" ::: "memory");
#pragma unroll 1
        for (int n_ = 0; n_ < NCH; ++n_) { const int n = n_ & 31, b = n_ & 1;
            if (PROBE_DUP == 4 && n_ == 32) {
#pragma unroll
                for (int i = 0; i < 8; ++i)
#pragma unroll
                    for (int q = 0; q < 16; ++q) St[i][q] = 0.f; }
            const LAS unsigned char* Bq = F.lds + b * GBUF; const LAS unsigned char* Bk = Bq + 64 * GQ_STR; const LAS unsigned char* Ba = Bk + 256 * GK_STR; const LAS unsigned char* Bd = Ba + 64 * GA_STR;
            const int r0 = (bseq * 32 + n) * 64;
            f32x16 OT[2];
#pragma unroll
            for (int tt = 0; tt < 2; ++tt)
#pragma unroll
                for (int q = 0; q < 16; ++q) OT[tt][q] = 0.f;
#pragma unroll
            for (int dt = 0; dt < 8; ++dt)
#pragma unroll
                for (int sx = 0; sx < 2; ++sx) {
                    const v4u ap = {pg8::cvt_pk_bf16(St[dt][8 * sx + 0], St[dt][8 * sx + 1]), pg8::cvt_pk_bf16(St[dt][8 * sx + 2], St[dt][8 * sx + 3]), pg8::cvt_pk_bf16(St[dt][8 * sx + 4], St[dt][8 * sx + 5]), pg8::cvt_pk_bf16(St[dt][8 * sx + 6], St[dt][8 * sx + 7])};
                    const bf16x8 Af = __builtin_bit_cast(bf16x8, ap);
#pragma unroll
                    for (int tt = 0; tt < 2; ++tt) { const LAS unsigned char* p = Bq + (32 * tt + r) * GQ_STR + (32 * dt + 16 * sx + 4 * hh) * 2;
                        const u32x2 lo = *(const LAS u32x2*)p, hi = *(const LAS u32x2*)(p + 16); const v4u bv = {lo.x, lo.y, hi.x, hi.y};
                        OT[tt] = __builtin_amdgcn_mfma_f32_32x32x16_bf16(Af, __builtin_bit_cast(bf16x8, bv), OT[tt], 0, 0, 0); } }
#pragma unroll
            for (int kk = 0; kk < 4; ++kk)
#pragma unroll
                for (int tt = 0; tt < 2; ++tt) { const bf16x8 Bf = *(const LAS bf16x8*)(Ba + (32 * tt + r) * GA_STR + (16 * kk + 8 * hh) * 2);
                    OT[tt] = __builtin_amdgcn_mfma_f32_32x32x16_bf16(vA[kk], Bf, OT[tt], 0, 0, 0); }
#pragma unroll
            for (int tt = 0; tt < 2; ++tt)
#pragma unroll
                for (int q = 0; q < 4; ++q) *(GAS unsigned long long*)(O + (size_t)(r0 + 32 * tt + r) * D + h * DV + ec + 8 * q + 4 * hh) =
                    (unsigned long long)pg8::cvt_pk_bf16(OT[tt][4 * q], OT[tt][4 * q + 1]) | ((unsigned long long)pg8::cvt_pk_bf16(OT[tt][4 * q + 2], OT[tt][4 * q + 3]) << 32);
#pragma unroll
            for (int tt = 0; tt < 2; ++tt) { float sq = 0.f;
#pragma unroll
                for (int q = 0; q < 16; ++q) sq += OT[tt][q] * OT[tt][q];
                sq += __shfl_xor(sq, 32);
                if (hh == 0) SSQ[((size_t)(r0 + 32 * tt + r) * 4 + h) * 16 + (j & 3) * 4 + wave] = sq; }
#pragma unroll
            for (int dt = 0; dt < 8; ++dt) {
                { const f32x4 d0 = *(const LAS f32x4*)(Bd + (32 * dt + 4 * hh) * 4), d1 = *(const LAS f32x4*)(Bd + (32 * dt + 8 + 4 * hh) * 4), d2 = *(const LAS f32x4*)(Bd + (32 * dt + 16 + 4 * hh) * 4), d3 = *(const LAS f32x4*)(Bd + (32 * dt + 24 + 4 * hh) * 4);
                  const f32x16 dv = {d0.x, d0.y, d0.z, d0.w, d1.x, d1.y, d1.z, d1.w, d2.x, d2.y, d2.z, d2.w, d3.x, d3.y, d3.z, d3.w}; St[dt] = St[dt] * dv; }
#pragma unroll
                for (int kk = 0; kk < 4; ++kk) { const bf16x8 Af = *(const LAS bf16x8*)(Bk + (32 * dt + r) * GK_STR + (16 * kk + 8 * hh) * 2);
                    St[dt] = __builtin_amdgcn_mfma_f32_32x32x16_bf16(Af, vA[kk], St[dt], 0, 0, 0); } }
            if (n_ + 1 < NCH) {
#pragma unroll
                for (int kk = 0; kk < 4; ++kk) vA[kk] = *(const GAS bf16x8*)(VT + ((size_t)(bh * DV + ec + r)) * 2048 + ((n_ + 1) & 31) * 64 + 16 * kk + 8 * hh); }
            asm volatile("s_waitcnt lgkmcnt(0)" ::: "memory"); __builtin_amdgcn_s_barrier(); asm volatile("" ::: "memory");
        }
        float* og = F.out + OUT_GLAP + ((size_t)(l * 4 + bseq) * 4 + h) * (size_t)(DK * DV);
#pragma unroll
        for (int dt = 0; dt < 8; ++dt)
#pragma unroll
            for (int q = 0; q < 16; ++q) og[(size_t)(32 * dt + (q & 3) + 8 * (q >> 2) + 4 * hh) * DV + ec + r] = St[dt][q];
    }
    __syncthreads();
}
__device__ __forceinline__ int cu_grab(Frame& F, int first, unsigned* ctr) {
    __syncthreads();
    if (F.tid == 0) F.MISC[16] = (unsigned)first + __hip_atomic_fetch_add(ctr, 1u, __ATOMIC_RELAXED, __HIP_MEMORY_SCOPE_AGENT);
    __syncthreads();
    return (int)__builtin_amdgcn_readfirstlane(F.MISC[16]);
}
__device__ __forceinline__ void gla_sample(Frame& F, int l, int wgi, int NW, unsigned* qctr) {
    unsigned char* ws = F.ws;
    const bf16* P = (const bf16*)(ws + WS_P);
    const float* QES = (const float*)(ws + WS_QES); const float* KDS = (const float*)(ws + WS_KDS); const float* DECS = (const float*)(ws + WS_DECS); const float* ATTS = (const float*)(ws + WS_ATTS);
    bf16* O = (bf16*)(ws + WS_O);
    const int lane = F.lane, c = lane & 15, g = lane >> 4;
    int grp = wgi >= 0 ? wgi : cu_grab(F, NW, qctr);
#pragma unroll 1
    for (; grp < NSQ * NH; grp = cu_grab(F, NW, qctr)) { const int it = grp * 8 + F.wave;
        const int es = it & 7, h = (it >> 3) & 3, s = it >> 5, rowb = s * 8, prow = MP + rowb;
        f32x4 vB[2];
#pragma unroll
        for (int kk = 0; kk < 2; ++kk) { typedef unsigned u32x2 __attribute__((ext_vector_type(2)));
            const u32x2 w = *(const GAS u32x2*)(P + P_V(prow + 4 * kk + g, h) + es * 64 + 4 * c); vB[kk] = (f32x4){bflo(w.x), bfhi(w.x), bflo(w.y), bfhi(w.y)}; }
        const size_t sbase = (((size_t)(l * NSQ + s) * NH + h) * DK) * DV + es * 64 + 4 * c;
        const float* S0 = F.stG + sbase + (size_t)(4 * g) * DV; float* SO = F.out + OUT_GLAS + sbase + (size_t)(4 * g) * DV;
        const float* qrow = QES + (size_t)(rowb + (c & 7)) * DQK + h * DK + 4 * g;
        const float* drow = DECS + (size_t)s * DQK + h * DK + 4 * g;
        const float* k0row = KDS + (size_t)(rowb + g) * DQK + h * DK + c; const float* k1row = KDS + (size_t)(rowb + 4 + g) * DQK + h * DK + c;
        f32x4 oacc[4];
#pragma unroll
        for (int jj = 0; jj < 4; ++jj) oacc[jj] = (f32x4){0.f, 0.f, 0.f, 0.f};
        f32x4 St[4][4], qa[4], d4[4]; float k0[4], k1[4];
#define GS_LOAD(sl, blk) do { const int dkl = 16 * (blk); \
        _Pragma("unroll") for (int i = 0; i < 4; ++i) St[sl][i] = *(const GAS f32x4*)(S0 + (size_t)(dkl + i) * DV); \
        qa[sl] = *(const GAS f32x4*)(qrow + dkl); d4[sl] = *(const GAS f32x4*)(drow + dkl); k0[sl] = k0row[dkl]; k1[sl] = k1row[dkl]; } while (0)
        GS_LOAD(0, 0); GS_LOAD(1, 1); GS_LOAD(2, 2);
#pragma unroll 1
        for (int b4 = 0; b4 < 16; b4 += 4) {
#pragma unroll
            for (int u = 0; u < 4; ++u) { const int blk = b4 + u, dk0 = 16 * blk;
                if (blk + 3 < 16) GS_LOAD((u + 3) & 3, blk + 3);
                f32x4 Cj[4];
#pragma unroll
                for (int jj = 0; jj < 4; ++jj) {
#pragma unroll
                    for (int i = 0; i < 4; ++i) oacc[jj] = __builtin_amdgcn_mfma_f32_16x16x4f32(qa[u][i], St[u][i][jj], oacc[jj], 0, 0, 0);
                    f32x4 C = {St[u][0][jj] * d4[u][0], St[u][1][jj] * d4[u][1], St[u][2][jj] * d4[u][2], St[u][3][jj] * d4[u][3]};
                    C = __builtin_amdgcn_mfma_f32_16x16x4f32(k0[u], vB[0][jj], C, 0, 0, 0); C = __builtin_amdgcn_mfma_f32_16x16x4f32(k1[u], vB[1][jj], C, 0, 0, 0); Cj[jj] = C; }
#pragma unroll
                for (int i = 0; i < 4; ++i) *(GAS f32x4*)(SO + (size_t)(dk0 + i) * DV) = (f32x4){Cj[0][i], Cj[1][i], Cj[2][i], Cj[3][i]};
            }
        }
#undef GS_LOAD
        const float* arow = ATTS + (((size_t)s * 4 + h) * 8 + (c & 7)) * 8 + g;
        const float aA0 = arow[0], aA1 = arow[4];
#pragma unroll
        for (int jj = 0; jj < 4; ++jj) { oacc[jj] = __builtin_amdgcn_mfma_f32_16x16x4f32(aA0, vB[0][jj], oacc[jj], 0, 0, 0); oacc[jj] = __builtin_amdgcn_mfma_f32_16x16x4f32(aA1, vB[1][jj], oacc[jj], 0, 0, 0); }
        if (g < 2) {
#pragma unroll
            for (int i = 0; i < 4; ++i) *(GAS unsigned long long*)(O + (size_t)(prow + 4 * g + i) * D + h * DV + es * 64 + 4 * c) =
                (unsigned long long)pk2(oacc[0][i], oacc[1][i]) | ((unsigned long long)pk2(oacc[2][i], oacc[3][i]) << 32);
        }
        { float* SSQ = (float*)(ws + WS_YB);
#pragma unroll
            for (int i = 0; i < 4; ++i) { float sq = (oacc[0][i] * oacc[0][i] + oacc[1][i] * oacc[1][i]) + (oacc[2][i] * oacc[2][i] + oacc[3][i] * oacc[3][i]);
                sq += __shfl_xor(sq, 1); sq += __shfl_xor(sq, 2); sq += __shfl_xor(sq, 4); sq += __shfl_xor(sq, 8);
                if (c == 0 && g < 2) { float* sp = SSQ + ((size_t)(prow + 4 * g + i) * 4 + h) * 16; sp[es] = sq; sp[8 + es] = 0.f; } } }
    }
}
struct MergeRow { v4u ov[4], og[4], ga[4], gb[4], yb[4]; };
__device__ __forceinline__ void merge_load(MergeRow& R, const bf16* O, const bf16* P, const bf16* YB, int r, int lane) {
#pragma unroll
    for (int h = 0; h < 4; ++h) { const int col = 512 * h + 8 * lane;
        R.ov[h] = *(const GAS v4u*)(O + (size_t)r * D + col); R.og[h] = *(const GAS v4u*)(P + P_OG(r, h) + 8 * lane); R.ga[h] = *(const GAS v4u*)(P + P_GA(r, h) + 8 * lane);
        R.gb[h] = *(const GAS v4u*)(P + P_GB(r, h) + 8 * lane); R.yb[h] = *(const GAS v4u*)(YB + (size_t)r * D + col); }
}
__device__ __forceinline__ void merge_compute(const MergeRow& R, Frame& F, bf16* MG, int l, int r, int lane) {
#pragma unroll
    for (int h = 0; h < 4; ++h) { const int col = 512 * h + 8 * lane;
        const v4u ov = R.ov[h], ogv = R.og[h], gav = R.ga[h], gbv = R.gb[h], ybv = R.yb[h];
        float o[8], res[8]; float ss = 0.f;
#pragma unroll
        for (int q = 0; q < 4; ++q) { o[2 * q] = bflo(ov[q]); o[2 * q + 1] = bfhi(ov[q]); ss += o[2 * q] * o[2 * q] + o[2 * q + 1] * o[2 * q + 1]; }
        const float rstd = 1.0f / sqrtf(wave_sum(ss) * (1.0f / DV) + EPS);
#pragma unroll
        for (int q = 0; q < 8; ++q) { const unsigned ow = ogv[q >> 1], aw = gav[q >> 1], bw = gbv[q >> 1], yw = ybv[q >> 1];
            const float og = (q & 1) ? bfhi(ow) : bflo(ow), ga = (q & 1) ? bfhi(aw) : bflo(aw), gb = (q & 1) ? bfhi(bw) : bflo(bw), yb = (q & 1) ? bfhi(yw) : bflo(yw);
            const float ya = o[q] * rstd * F.gla_norm_g[(size_t)l * DV + 8 * lane + q] * (og * sigmoidf_(og));
            res[q] = sigmoidf_(ga) * ya + sigmoidf_(gb) * (yb * F.pool_scale[(size_t)l * D + col + q]); }
        *(GAS v4u*)(MG + (size_t)r * D + col) = (v4u){pk2(res[0], res[1]), pk2(res[2], res[3]), pk2(res[4], res[5]), pk2(res[6], res[7])};
    }
}
__device__ __forceinline__ void merge_rows(Frame& F, int l) {
    unsigned char* ws = F.ws;
    const bf16* P = (const bf16*)(ws + WS_P); const bf16* O = (const bf16*)(ws + WS_O); const bf16* YB = (const bf16*)(ws + WS_YB); bf16* MG = (bf16*)(ws + WS_MG);
    const int gw = F.vcu * NWAVES + F.wave, NGW = F.G * NWAVES, lane = F.lane;
    MergeRow A, B;
    if (gw < M) merge_load(A, O, P, YB, gw, lane);
#pragma unroll 1
    for (int r = gw; r < M; r += 2 * NGW) {
        const int r1 = r + NGW, r2 = r + 2 * NGW;
        if (r1 < M) merge_load(B, O, P, YB, r1, lane);
        merge_compute(A, F, MG, l, r, lane);
        if (r2 < M) merge_load(A, O, P, YB, r2, lane);
        if (r1 < M) merge_compute(B, F, MG, l, r1, lane);
    }
}

__device__ __forceinline__ float sgm_(float x) { return __builtin_amdgcn_rcpf(1.0f + __builtin_amdgcn_exp2f(-1.44269504089f * x)); }
__device__ __forceinline__ void poolmerge_phase(Frame& F, int l, int rb0) {
    unsigned char* ws = F.ws;
    const bf16* P = (const bf16*)(ws + WS_P); const bf16* O = (const bf16*)(ws + WS_O); const bf16* DM = (const bf16*)(ws + WS_DM); const bf16* WPL = (const bf16*)(ws + WS_WPL + (size_t)l * 1 * MiB);
    const float* SSQ = (const float*)(ws + WS_YB); bf16* MG = (bf16*)(ws + WS_MG);
    const float* gng = F.gla_norm_g + (size_t)l * DV; const float* psc = F.pool_scale + (size_t)l * D;
    const int gw = F.vcu * NWAVES + F.wave, NGW = F.G * NWAVES, lane = F.lane, c = lane & 15, g4 = lane >> 4;
#pragma unroll 1
    for (int it = rb0 * 16 + gw; it < (M / 16) * 16; it += NGW) {
        const int cq = it & 3, h = (it >> 2) & 3, row = (it >> 4) * 16 + c, cb = 128 * cq + 32 * g4;
        bf16x8 dB[8];
#pragma unroll
        for (int kk = 0; kk < 8; ++kk) dB[kk] = *(const GAS bf16x8*)(DM + (size_t)row * DPOOL + 256 * h + 32 * kk + 8 * g4);
        const bf16* wrow = WPL + (size_t)(512 * h + 128 * cq + 32 * (c >> 2) + (c & 3)) * 256 + 8 * g4;
        f32x4 acc[8];
#pragma unroll
        for (int nt = 0; nt < 8; ++nt) { acc[nt] = (f32x4){0.f, 0.f, 0.f, 0.f};
#pragma unroll
            for (int kk = 0; kk < 8; ++kk) { const bf16x8 Af = *(const GAS bf16x8*)(wrow + (size_t)(4 * nt) * 256 + 32 * kk);
                acc[nt] = __builtin_amdgcn_mfma_f32_16x16x32_bf16(Af, dB[kk], acc[nt], 0, 0, 0); } }
        const GAS f32x4* sp = (const GAS f32x4*)(SSQ + ((size_t)row * 4 + h) * 16); const f32x4 s0 = sp[0], s1 = sp[1], s2 = sp[2], s3 = sp[3];
        const float ss = ((s0[0] + s0[1]) + (s0[2] + s0[3])) + ((s1[0] + s1[1]) + (s1[2] + s1[3])) + ((s2[0] + s2[1]) + (s2[2] + s2[3])) + ((s3[0] + s3[1]) + (s3[2] + s3[3]));
        const float rstd = __builtin_amdgcn_rsqf(ss * (1.0f / DV) + EPS);
        v4u ov[4], ogv[4], gav[4], gbv[4];
#pragma unroll
        for (int q = 0; q < 4; ++q) { ov[q] = *(const GAS v4u*)(O + (size_t)row * D + 512 * h + cb + 8 * q); ogv[q] = *(const GAS v4u*)(P + P_OG(row, h) + cb + 8 * q);
            gav[q] = *(const GAS v4u*)(P + P_GA(row, h) + cb + 8 * q); gbv[q] = *(const GAS v4u*)(P + P_GB(row, h) + cb + 8 * q); }
#pragma unroll
        for (int q = 0; q < 4; ++q) { float res[8];
            const f32x4 gn0 = *(const GAS f32x4*)(gng + cb + 8 * q), gn1 = *(const GAS f32x4*)(gng + cb + 8 * q + 4), ps0 = *(const GAS f32x4*)(psc + 512 * h + cb + 8 * q), ps1 = *(const GAS f32x4*)(psc + 512 * h + cb + 8 * q + 4);
#pragma unroll
            for (int e = 0; e < 8; ++e) { const unsigned ow = ov[q][e >> 1], gw_ = ogv[q][e >> 1], aw = gav[q][e >> 1], bw = gbv[q][e >> 1];
                const float o = (e & 1) ? bfhi(ow) : bflo(ow), og = (e & 1) ? bfhi(gw_) : bflo(gw_), ga = (e & 1) ? bfhi(aw) : bflo(aw), gb = (e & 1) ? bfhi(bw) : bflo(bw);
                const float gn = e < 4 ? gn0[e & 3] : gn1[e & 3], ps = e < 4 ? ps0[e & 3] : ps1[e & 3], yb = acc[2 * q + (e >> 2)][e & 3] * ps;
                res[e] = sgm_(ga) * (o * rstd * gn * (og * sgm_(og))) + sgm_(gb) * yb; }
            *(GAS v4u*)(MG + (size_t)row * D + 512 * h + cb + 8 * q) = (v4u){pk2(res[0], res[1]), pk2(res[2], res[3]), pk2(res[4], res[5]), pk2(res[6], res[7])}; }
    }
}

__device__ __forceinline__ bool probe_group(int k) {
    const int j = (k >= 2 && k < 22) ? (k - 2) % 10 : -1;
    const bool gemm = (j == 1 || j == 4 || j == 6 || j == 8 || j == 9), mix = (j == 2 || j == 3);
    if (PROBE_DUP >= 30 && PROBE_DUP < 40) return j == PROBE_DUP - 30;
    if (PROBE_DUP >= 50) return false;
    if (PROBE_DUP >= 40) return k == (PROBE_DUP == 40 ? 0 : PROBE_DUP == 41 ? 1 : 22);
    return PROBE_DUP == 21 ? gemm : PROBE_DUP == 22 ? mix : PROBE_DUP == 23 ? !(gemm || mix) : false;
}
#define IN(k) (lo <= (k) && (k) < hi)
#define SEAM(k) do { if (IN(k) && IN((k) + 1)) { xcd_barrier(bar); if (PROBE_DUP == 7) xcd_barrier(bar); } if (PROBE_DUP >= 21) { const unsigned long long now_ = __builtin_amdgcn_s_memrealtime(); if (probe_group(k)) tsum += now_ - tlast; tlast = now_; } } while (0)
template <int l>
__device__ __forceinline__ void layer_phases(Frame& F, const XcdBarrier& bar, const int lo, const int hi, unsigned long long& tsum, unsigned long long& tlast) {
    unsigned char* ws = F.ws;
    float* MOD = (float*)(ws + WS_MOD); bf16* XN = (bf16*)(ws + WS_XN); bf16* Pm = (bf16*)(ws + WS_P);
    float* X1 = (float*)(ws + WS_X1); float* X2 = (float*)(ws + WS_X2); bf16* SLAB = (bf16*)(ws + WS_SLAB);
        const int pb = 2 + 10 * l;
        const float* xinP = l == 0 ? F.xP : X2; const float* xinS = l == 0 ? F.xS : X2 + (size_t)MP * D;
        const float* modl = MOD + (size_t)l * NADA;
        if (IN(pb + 0)) for (int rep_ = 0; rep_ < (PROBE_DUP == 8 ? 2 : 1); ++rep_) { if (l == 0) norm_rows(F, xinP, xinS, F.norm1_g + (size_t)l * D, modl, XN, nullptr, nullptr, nullptr, nullptr);
                          else norm_rows(F, xinP, xinS, F.norm1_g + (size_t)l * D, modl, XN, SLAB, X1 + (size_t)MP * D, MOD + (size_t)(l - 1) * NADA + 5 * D, X2); }
        SEAM(pb + 0);
        if (IN(pb + 1)) {
            pg8::Gemm g{XN, (const bf16*)(ws + WS_WIN + (size_t)l * 45 * MiB), M, NINP, D, D, D, 1, 0}; pg8::StaticOrder S; S.init(M, NINP, F.G, (int)blockIdx.x, D);
            pg8::EpiWin E{Pm, M};
            for (int rep_ = 0; rep_ < (PROBE_DUP == 6 ? 2 : 1); ++rep_) pg8::gemm_phase<pg8::EpiWin, pg8::StaticOrder, true, true>(F.lds, g, S, E);
            if (l == 0) conv_in_tail<CV_PL | CV_O | CV_GU | CV_DN>(F, 0, S.nwg); else conv_in_tail<CV_GU>(F, 1, S.nwg);
        }
        SEAM(pb + 1);
#ifndef NO_PREP
        if (IN(pb + 2)) { for (int rep_ = 0; rep_ < (PROBE_DUP == 2 ? 2 : 1); ++rep_) {
            unsigned long long tq0_ = 0ull; if (PROBE_DUP == 52 || PROBE_DUP == 53) tq0_ = __builtin_amdgcn_s_memrealtime();
            prep_phase(F, l);
            if (PROBE_DUP == 52 || PROBE_DUP == 53) { xcd_barrier(bar); const unsigned long long t1_ = __builtin_amdgcn_s_memrealtime(); if (PROBE_DUP == 52) tsum += t1_ - tq0_; tq0_ = t1_; }
            pool_rows(F, l);
            if (PROBE_DUP == 52 || PROBE_DUP == 53) { xcd_barrier(bar); const unsigned long long t1_ = __builtin_amdgcn_s_memrealtime(); if (PROBE_DUP == 53) tsum += t1_ - tq0_; } } }
#endif
        SEAM(pb + 2);
        if (IN(pb + 3)) {
            if (F.G >= 128) {
                unsigned long long tq0_ = 0ull;
                if (PROBE_DUP == 50 || PROBE_DUP == 51) tq0_ = __builtin_amdgcn_s_memrealtime();
                unsigned* qctr = (unsigned*)(F.ctl + CW_GLAQ + 64 * l);
                if ((int)blockIdx.x < 64) { gla_prompt(F, l); gla_sample(F, l, -1, F.G - 64, qctr); }
                if (PROBE_DUP == 50 || PROBE_DUP == 51) { xcd_barrier(bar); const unsigned long long t1_ = __builtin_amdgcn_s_memrealtime(); if (PROBE_DUP == 50) tsum += t1_ - tq0_; tq0_ = t1_; }
                if ((int)blockIdx.x >= 64) gla_sample(F, l, (int)blockIdx.x - 64, F.G - 64, qctr);
                if (PROBE_DUP == 50 || PROBE_DUP == 51) { xcd_barrier(bar); const unsigned long long t1_ = __builtin_amdgcn_s_memrealtime(); if (PROBE_DUP == 51) tsum += t1_ - tq0_; }
            }
        }
        SEAM(pb + 3);
        if (IN(pb + 4)) {
            pg8::Gemm g{(const bf16*)(ws + WS_DM), (const bf16*)(ws + WS_WPL + (size_t)l * 1 * MiB), MP, D, 256, DPOOL, 256, 2, 512}; pg8::StaticOrder S; S.init(MP, D, F.G, (int)blockIdx.x, 256);
            pg8::EpiMerge E{(bf16*)(ws + WS_MG), (const bf16*)(ws + WS_O), Pm, (const float*)(ws + WS_YB), F.gla_norm_g + (size_t)l * DV, F.pool_scale + (size_t)l * D, M};
            for (int rep_ = 0; rep_ < (PROBE_DUP == 10 ? 2 : 1); ++rep_) pg8::gemm_phase<pg8::EpiMerge, pg8::StaticOrder, true, true>(F.lds, g, S, E);
            poolmerge_phase(F, l, MP / 16);
        }
        SEAM(pb + 4);
#ifndef NO_MERGE
#endif
        if (IN(pb + 6)) {
            pg8::Gemm g{(const bf16*)(ws + WS_MG), (const bf16*)(ws + WS_WO + (size_t)l * 8 * MiB), M, D, D, D, D, 1, 0}; pg8::SplitOrder S; S.init(F.G, (int)blockIdx.x, D);
            pg8::EpiResGate E{xinP, xinS, X1, D, modl + 2 * D, NMOD, SLAB};
            for (int rep_ = 0; rep_ < (PROBE_DUP == 10 ? 2 : 1); ++rep_) pg8::gemm_phase<pg8::EpiResGate, pg8::SplitOrder, true, true>(F.lds, g, S, E);
        }
        SEAM(pb + 6);
        if (IN(pb + 7)) for (int rep_ = 0; rep_ < (PROBE_DUP == 8 ? 2 : 1); ++rep_) norm_rows(F, X1, X1 + (size_t)MP * D, F.norm2_g + (size_t)l * D, modl + 3 * D, XN, SLAB, xinS, modl + 2 * D, X1);
        SEAM(pb + 7);
        if (IN(pb + 8)) {
            pg8::Gemm g{XN, (const bf16*)(ws + WS_WGU + (size_t)l * 44 * MiB), M, NGU, D, D, D, 1, 0}; pg8::StaticOrder S; S.init(M, NGU, F.G, (int)blockIdx.x, D);
            pg8::EpiSwiGLU E{(bf16*)(ws + WS_ACT), DFF};
            for (int rep_ = 0; rep_ < (PROBE_DUP == 9 ? 2 : 1); ++rep_) pg8::gemm_phase<pg8::EpiSwiGLU, pg8::StaticOrder, true, true>(F.lds, g, S, E);
            if (l == 0) conv_in_tail<CV_IN | CV_PL | CV_O | CV_DN>(F, 1, S.nwg);
        }
        SEAM(pb + 8);
        if (IN(pb + 9)) {
            pg8::Gemm g{(const bf16*)(ws + WS_ACT), (const bf16*)(ws + WS_WDN + (size_t)l * 22 * MiB), M, D, DFF, DFF, DFF, 1, 0}; pg8::SplitOrder S; S.init(F.G, (int)blockIdx.x, DFF);
            pg8::EpiResGate E{X1, X1 + (size_t)MP * D, X2, D, modl + 5 * D, NMOD, SLAB};
            for (int rep_ = 0; rep_ < (PROBE_DUP == 5 ? 2 : 1); ++rep_) pg8::gemm_phase<pg8::EpiResGate, pg8::SplitOrder, true, true>(F.lds, g, S, E);
        }
        SEAM(pb + 9);
    }
#undef IN
#undef SEAM

constexpr int NPHASE = 23;
struct Args { const float* in[20]; float* out; unsigned char* ws; int ph_lo, ph_hi; };
__global__ void __launch_bounds__(NWAVES * 64, 2) fwd(Args args) {
    extern __shared__ __attribute__((aligned(16))) unsigned char lds[];
    Frame F;
    F.lds = (LAS unsigned char*)lds; F.MISC = (volatile LAS unsigned*)(F.lds + MISC_OFF);
    F.tid = threadIdx.x; F.lane = F.tid & 63; F.wave = __builtin_amdgcn_readfirstlane(F.tid >> 6);
    F.G = gridDim.x; { const int bx = blockIdx.x; F.vcu = (F.G % 8 == 0) ? (bx % 8) * (F.G / 8) + bx / 8 : bx; }
    F.xP = args.in[0]; F.xS = args.in[1]; F.stG = args.in[2]; F.stP = args.in[3]; F.cP = args.in[4]; F.cS = args.in[5]; F.w_ada = args.in[6]; F.b_ada = args.in[7]; F.norm1_g = args.in[8];
    F.w_in = args.in[9]; F.w_a2 = args.in[10]; F.b_a = args.in[11]; F.gla_norm_g = args.in[12]; F.w_pool = args.in[13]; F.pool_scale = args.in[14]; F.w_o = args.in[15]; F.norm2_g = args.in[16];
    F.w_gu = args.in[17]; F.w_down = args.in[18]; F.final_g = args.in[19]; F.out = args.out; F.ws = args.ws;
    unsigned char* ws = args.ws;
    F.ctl = (gu32*)(ws + WS_CTL);
    if (F.tid < 64) F.MISC[F.tid] = 0u;
    __syncthreads();
    const int lo = args.ph_lo, hi = args.ph_hi;
    XcdBarrier bar; bar.bar = (unsigned*)(F.ctl + CW_BAR); bar.x = 0; bar.st = nullptr;
    if (hi - lo > 1) bar = xcd_barrier_post((unsigned*)(F.ctl + CW_BAR), F.MISC + 8);
    unsigned long long tsum = 0ull, tlast = (PROBE_DUP >= 21) ? __builtin_amdgcn_s_memrealtime() : 0ull;
#define IN(k) (lo <= (k) && (k) < hi)
#define SEAM(k) do { if (IN(k) && IN((k) + 1)) { xcd_barrier(bar); if (PROBE_DUP == 7) xcd_barrier(bar); } if (PROBE_DUP >= 21) { const unsigned long long now_ = __builtin_amdgcn_s_memrealtime(); if (probe_group(k)) tsum += now_ - tlast; tlast = now_; } } while (0)
    float* MOD = (float*)(ws + WS_MOD); bf16* XN = (bf16*)(ws + WS_XN); bf16* Pm = (bf16*)(ws + WS_P);
    float* X1 = (float*)(ws + WS_X1); float* X2 = (float*)(ws + WS_X2);

#ifndef NO_P0
    if (IN(0)) { for (int rep_ = 0; rep_ < (PROBE_DUP == 1 ? 2 : 1); ++rep_) { p0_convert(F); if (PROBE_DUP == 1) { __syncthreads(); } } }
#endif
    SEAM(0);
    if (IN(1)) { unsigned long long tq0_ = 0ull; if (PROBE_DUP == 54 || PROBE_DUP == 55) tq0_ = __builtin_amdgcn_s_memrealtime();
        ada_direct(F);
        if (PROBE_DUP == 54 || PROBE_DUP == 55) { xcd_barrier(bar); const unsigned long long t1_ = __builtin_amdgcn_s_memrealtime(); if (PROBE_DUP == 54) tsum += t1_ - tq0_; tq0_ = t1_; }
        conv_set<CV_IN>(F, 0, F.vcu * NWAVES + F.wave, F.G * NWAVES);
        if (PROBE_DUP == 54 || PROBE_DUP == 55) { xcd_barrier(bar); const unsigned long long t1_ = __builtin_amdgcn_s_memrealtime(); if (PROBE_DUP == 55) tsum += t1_ - tq0_; } }
    SEAM(1);
    layer_phases<0>(F, bar, lo, hi, tsum, tlast);
    layer_phases<1>(F, bar, lo, hi, tsum, tlast);
    if (IN(22)) for (int rep_ = 0; rep_ < (PROBE_DUP == 8 ? 2 : 1); ++rep_) final_norm(F, X2, (const bf16*)(ws + WS_SLAB), X1 + (size_t)MP * D, MOD + (size_t)NADA + 5 * D);
    if (PROBE_DUP >= 21 && blockIdx.x == 0 && F.wave == 0) { const unsigned long long now_ = __builtin_amdgcn_s_memrealtime(); if (probe_group(22)) tsum += now_ - tlast;
        const unsigned long long tend = now_ + tsum; while (__builtin_amdgcn_s_memrealtime() < tend) __builtin_amdgcn_s_sleep(8); }
#undef IN
#undef SEAM
}

extern "C" void kernel_launch(void* const* d_in, const int* in_sizes, int n_in, void* d_out, int out_size, void* d_ws, size_t ws_size, hipStream_t stream) {
    static int grid = 0;
    if (grid == 0) {
        if (n_in != 20 || (size_t)out_size != OUT_END || ws_size < WS_END) { fprintf(stderr, "kernel_launch: unexpected shapes (n_in %d, out %d, ws %zu)\n", n_in, out_size, ws_size); grid = -1; return; }
        int dev = 0, cus = 0, per_cu = 0;
        if (hipGetDevice(&dev) != hipSuccess || hipDeviceGetAttribute(&cus, hipDeviceAttributeMultiprocessorCount, dev) != hipSuccess) { grid = -1; return; }
        if (hipFuncSetAttribute((const void*)fwd, hipFuncAttributeMaxDynamicSharedMemorySize, LDS_BYTES) != hipSuccess) { fprintf(stderr, "kernel_launch: hipFuncSetAttribute failed\n"); grid = -1; return; }
        if (hipOccupancyMaxActiveBlocksPerMultiprocessor(&per_cu, (const void*)fwd, NWAVES * 64, LDS_BYTES) != hipSuccess || per_cu < 1) fprintf(stderr, "kernel_launch: occupancy query says %d\n", per_cu);
        (void)hipGetLastError();
        grid = cus;
    }
    if (grid < 0) return;
    if (hipMemsetAsync((char*)d_ws + WS_CTL, 0, CTL_ZERO_BYTES, stream) != hipSuccess) return;
    Args a{};
    for (int i = 0; i < 20; ++i) a.in[i] = (const float*)d_in[i];
    a.out = (float*)d_out; a.ws = (unsigned char*)d_ws;
#if MK_N_LAUNCHES == 1
    a.ph_lo = 0; a.ph_hi = NPHASE;
    hipLaunchKernelGGL(fwd, dim3(grid), dim3(NWAVES * 64), LDS_BYTES, stream, a);
#else
    for (int p = 0; p < NPHASE; ++p) { a.ph_lo = p; a.ph_hi = p + 1; hipLaunchKernelGGL(fwd, dim3(grid), dim3(NWAVES * 64), LDS_BYTES, stream, a); }
#endif
}
```
